# Optimizing an MI355X kernel written in HIP

```python
import math
import jax, jax.numpy as jnp
from jax import lax
import numpy as np


D_MODEL = 4096
BATCH = 4
SEQ = 4096
DEPTH = 1

HEAD_DIM = 128
N_MOBA_HEADS = 16
N_SWA_HEADS = 16
N_SWA_KV_HEADS = 4
MOBA_BLOCK = 256
MOBA_TOPK = 3
MOBA_QCHUNK = 64
SWA_WINDOW = 128
SWA_BLOCK = 128
N_MEM = 256
N_CROSS_HEADS = 4
D_FF = 11008
NUM_BUCKETS = 32
MAX_DISTANCE = 128
EPS = 1e-6

MOBA_W = N_MOBA_HEADS * HEAD_DIM
SWA_W = N_SWA_HEADS * HEAD_DIM
SWA_KV_W = N_SWA_KV_HEADS * HEAD_DIM
CROSS_W = N_CROSS_HEADS * HEAD_DIM
MIX_W = MOBA_W + SWA_W
IN_W = 3 * MOBA_W + SWA_W + 2 * SWA_KV_W

kernel_name = 'hymba_moba_swa_sink_macaron_t5'


def rms_norm(x, g):
    xf = x.astype(jnp.float32)
    y = xf * lax.rsqrt(jnp.mean(xf * xf, axis=-1, keepdims=True) + EPS)
    return (y * g.astype(jnp.float32)).astype(x.dtype)


def swiglu(x, w_gate, w_up, w_down):
    return (jax.nn.silu(x @ w_gate) * (x @ w_up)) @ w_down


def t5_bucket(dist):
    n = jnp.maximum(dist, 0)
    max_exact = NUM_BUCKETS // 2
    nf = jnp.maximum(n, max_exact).astype(jnp.float32)
    large = max_exact + (jnp.log(nf / max_exact) / math.log(MAX_DISTANCE / max_exact)
                         * (NUM_BUCKETS - max_exact)).astype(jnp.int32)
    large = jnp.minimum(large, NUM_BUCKETS - 1)
    return jnp.where(n < max_exact, n, large)


def moba_attention(q, k, v, bias_hb):
    b_, s_, h_, d_ = q.shape
    L = MOBA_BLOCK
    nb = -(-s_ // L)
    topk = min(MOBA_TOPK, nb)
    pad = nb * L - s_

    def to_blocks(t):
        t = jnp.pad(t, ((0, 0), (0, pad), (0, 0), (0, 0)))
        return t.reshape(b_, nb, L, h_, d_).transpose(0, 3, 1, 2, 4)

    k_blk = to_blocks(k)
    v_blk = to_blocks(v)
    k_mean = jnp.mean(k_blk.astype(jnp.float32), axis=3)
    n_chunks = s_ // MOBA_QCHUNK
    q_c = q.reshape(b_, n_chunks, MOBA_QCHUNK, h_, d_).transpose(0, 1, 3, 2, 4)
    q_c = q_c.reshape(b_ * n_chunks, h_, MOBA_QCHUNK, d_)
    b_idx = jnp.repeat(jnp.arange(b_, dtype=jnp.int32), n_chunks)
    c_idx = jnp.tile(jnp.arange(n_chunks, dtype=jnp.int32), b_)
    scale = d_ ** -0.5
    blk_ids = jnp.arange(nb, dtype=jnp.int32)
    t_ids = jnp.arange(L, dtype=jnp.int32)
    gather = jax.vmap(lambda tb, ib: tb[ib])

    def one_chunk(args):
        qc, bi, ci = args
        kb, vb, km = k_blk[bi], v_blk[bi], k_mean[bi]
        q_pos = ci * MOBA_QCHUNK + jnp.arange(MOBA_QCHUNK, dtype=jnp.int32)
        own = (ci * MOBA_QCHUNK) // L
        gate = jnp.einsum('hqd,hnd->hqn', qc.astype(jnp.float32), km)
        gate = jnp.where(blk_ids < own, gate, -jnp.inf)
        _, sel = lax.top_k(gate, topk)
        valid = sel < own
        k_sel = gather(kb, sel)
        v_sel = gather(vb, sel)
        k_pos_sel = sel[..., None] * L + t_ids
        bkt_sel = t5_bucket(q_pos[None, :, None, None] - k_pos_sel).reshape(h_, -1)
        b_sel = jnp.take_along_axis(bias_hb, bkt_sel, axis=1).reshape(k_pos_sel.shape)
        s_sel = jnp.einsum('hqd,hqkld->hqkl', qc, k_sel).astype(jnp.float32) * scale + b_sel
        s_sel = jnp.where(valid[..., None], s_sel, -jnp.inf)
        k_own = lax.dynamic_index_in_dim(kb, own, axis=1, keepdims=False)
        v_own = lax.dynamic_index_in_dim(vb, own, axis=1, keepdims=False)
        d_own = q_pos[:, None] - (own * L + t_ids)[None, :]
        s_own = jnp.einsum('hqd,hld->hql', qc, k_own).astype(jnp.float32) * scale + bias_hb[:, t5_bucket(d_own)]
        s_own = jnp.where(d_own >= 0, s_own, -jnp.inf)
        logits = jnp.concatenate([s_sel.reshape(h_, MOBA_QCHUNK, topk * L), s_own], axis=-1)
        p = jax.nn.softmax(logits, axis=-1).astype(v.dtype)
        p_sel = p[..., :topk * L].reshape(h_, MOBA_QCHUNK, topk, L)
        p_own = p[..., topk * L:]
        return jnp.einsum('hqkl,hqkld->hqd', p_sel, v_sel) + jnp.einsum('hql,hld->hqd', p_own, v_own)

    out = lax.map(one_chunk, (q_c, b_idx, c_idx))
    out = out.reshape(b_, n_chunks, h_, MOBA_QCHUNK, d_).transpose(0, 1, 3, 2, 4)
    return out.reshape(b_, s_, h_, d_)


def swa_sink_attention(q, k, v, sinks, bias_hb):
    b_, s_, hq, d_ = q.shape
    hkv = k.shape[2]
    g_ = hq // hkv
    L = SWA_BLOCK
    nq = s_ // L
    qb = q.reshape(b_, nq, L, hkv, g_, d_)

    def band(t):
        prev = jnp.pad(t, ((0, 0), (L, 0), (0, 0), (0, 0)))[:, :s_]
        return jnp.concatenate([prev.reshape(b_, nq, L, hkv, d_), t.reshape(b_, nq, L, hkv, d_)], axis=2)

    kb, vb = band(k), band(v)
    scale = d_ ** -0.5
    i = jnp.arange(L, dtype=jnp.int32)[:, None]
    j = jnp.arange(2 * L, dtype=jnp.int32)[None, :]
    dist = i + L - j
    bias = bias_hb[:, t5_bucket(dist)].reshape(hkv, g_, 1, L, 2 * L)
    k_pos = (jnp.arange(nq, dtype=jnp.int32)[:, None, None] - 1) * L + j[None]
    mask = (dist >= 0) & (dist < SWA_WINDOW) & (k_pos >= 0)
    s = jnp.einsum('bnqhgd,bnkhd->bhgnqk', qb, kb).astype(jnp.float32) * scale + bias
    s = jnp.where(mask, s, -jnp.inf)
    sink = jnp.broadcast_to(sinks.astype(jnp.float32).reshape(1, hkv, g_, 1, 1, 1), s.shape[:-1] + (1,))
    p = jax.nn.softmax(jnp.concatenate([s, sink], axis=-1), axis=-1)[..., :-1].astype(v.dtype)
    o = jnp.einsum('bhgnqk,bnkhd->bnqhgd', p, vb)
    return o.reshape(b_, s_, hq, d_)


def cross_attention(n, mem_n, w_q, w_k, w_v, w_o):
    b_, s_, _ = n.shape
    m_ = mem_n.shape[1]
    q = (n @ w_q).reshape(b_, s_, N_CROSS_HEADS, HEAD_DIM)
    k = (mem_n @ w_k).reshape(b_, m_, N_CROSS_HEADS, HEAD_DIM)
    v = (mem_n @ w_v).reshape(b_, m_, N_CROSS_HEADS, HEAD_DIM)
    s = jnp.einsum('bshd,bmhd->bhsm', q, k).astype(jnp.float32) * (HEAD_DIM ** -0.5)
    p = jax.nn.softmax(s, axis=-1).astype(v.dtype)
    o = jnp.einsum('bhsm,bmhd->bshd', p, v).reshape(b_, s_, CROSS_W)
    return o @ w_o


def setup_inputs(seed: int = 0) -> dict:
    key = jax.random.key(seed)
    ks = jax.random.split(key, 32)
    f32 = jnp.float32
    L, D = DEPTH, D_MODEL

    def nrm(k, shape, scale):
        return jax.random.normal(k, shape, f32) * scale

    def gain(k, shape):
        return 1.0 + 0.02 * jax.random.normal(k, shape, f32)

    return {
        'x': nrm(ks[0], (BATCH, SEQ, D), 1.0),
        'mem': nrm(ks[1], (BATCH, N_MEM, D), 1.0),
        'rel_bias': nrm(ks[2], (NUM_BUCKETS, N_MOBA_HEADS + N_SWA_HEADS), 0.5),
        'g_final': gain(ks[3], (D,)),
        'g_ffn1': gain(ks[4], (L, D)),
        'w1_gate': nrm(ks[5], (L, D, D_FF), D ** -0.5),
        'w1_up': nrm(ks[6], (L, D, D_FF), D ** -0.5),
        'w1_down': nrm(ks[7], (L, D_FF, D), D_FF ** -0.5),
        'g_mix': gain(ks[8], (L, D)),
        'w_in': nrm(ks[9], (L, D, IN_W), D ** -0.5),
        'b_in': nrm(ks[10], (L, IN_W), 0.02),
        'sinks': nrm(ks[11], (L, N_SWA_HEADS), 0.5),
        'g_out_moba': gain(ks[12], (L, MOBA_W)),
        'g_out_swa': gain(ks[13], (L, SWA_W)),
        'w_out': nrm(ks[14], (L, MIX_W, D), MIX_W ** -0.5),
        'g_cross': gain(ks[15], (L, D)),
        'g_mem': gain(ks[16], (L, D)),
        'w_cq': nrm(ks[17], (L, D, CROSS_W), D ** -0.5),
        'w_ck': nrm(ks[18], (L, D, CROSS_W), D ** -0.5),
        'w_cv': nrm(ks[19], (L, D, CROSS_W), D ** -0.5),
        'w_co': nrm(ks[20], (L, CROSS_W, D), CROSS_W ** -0.5),
        'g_ffn2': gain(ks[21], (L, D)),
        'w2_gate': nrm(ks[22], (L, D, D_FF), D ** -0.5),
        'w2_up': nrm(ks[23], (L, D, D_FF), D ** -0.5),
        'w2_down': nrm(ks[24], (L, D_FF, D), D_FF ** -0.5),
    }


def reference(x, mem, rel_bias, g_final, g_ffn1, w1_gate, w1_up, w1_down, g_mix, w_in, b_in, sinks,
              g_out_moba, g_out_swa, w_out, g_cross, g_mem, w_cq, w_ck, w_cv, w_co,
              g_ffn2, w2_gate, w2_up, w2_down):
    b_, s_, _ = x.shape
    bias_moba = rel_bias[:, :N_MOBA_HEADS].T.astype(jnp.float32)
    bias_swa = rel_bias[:, N_MOBA_HEADS:].T.astype(jnp.float32)
    splits = [int(c) for c in np.cumsum([MOBA_W, MOBA_W, MOBA_W, SWA_W, SWA_KV_W])]
    for l in range(DEPTH):
        x = x + 0.5 * swiglu(rms_norm(x, g_ffn1[l]), w1_gate[l], w1_up[l], w1_down[l])
        n = rms_norm(x, g_mix[l])
        proj = n @ w_in[l] + b_in[l]
        qm, km, vm, qs, ksw, vsw = jnp.split(proj, splits, axis=-1)
        hm = (b_, s_, N_MOBA_HEADS, HEAD_DIM)
        o_m = moba_attention(qm.reshape(hm), km.reshape(hm), vm.reshape(hm), bias_moba)
        o_s = swa_sink_attention(qs.reshape(b_, s_, N_SWA_HEADS, HEAD_DIM),
                                 ksw.reshape(b_, s_, N_SWA_KV_HEADS, HEAD_DIM),
                                 vsw.reshape(b_, s_, N_SWA_KV_HEADS, HEAD_DIM),
                                 sinks[l], bias_swa)
        o = jnp.concatenate([rms_norm(o_m.reshape(b_, s_, MOBA_W), g_out_moba[l]),
                             rms_norm(o_s.reshape(b_, s_, SWA_W), g_out_swa[l])], axis=-1)
        x = x + o @ w_out[l]
        x = x + cross_attention(rms_norm(x, g_cross[l]), rms_norm(mem, g_mem[l]),
                                w_cq[l], w_ck[l], w_cv[l], w_co[l])
        x = x + 0.5 * swiglu(rms_norm(x, g_ffn2[l]), w2_gate[l], w2_up[l], w2_down[l])
    return rms_norm(x, g_final)
```

```cpp
#include <hip/hip_runtime.h>
#include <cstdio>
#include <cstdint>
#include <cmath>
namespace pg8 {
#define PG8_LAS __attribute__((address_space(3)))
typedef unsigned short bf16_t;
typedef short bf16x8 __attribute__((ext_vector_type(8)));
typedef float f32x4 __attribute__((ext_vector_type(4)));
typedef unsigned u32x4 __attribute__((ext_vector_type(4)));
constexpr int BM = 256, BK = 64, HALF = 128, HTB = HALF * BK * 2  , STAGE_BYTES = 8 * HTB, NXCD = 8, WGM = 8;

__host__ __device__ __forceinline__ int lds_byte(int r, int c) { const int st = (r >> 4) * 2 + (c >> 5), rr = r & 15, cc = c & 31, ob = rr * 64 + cc * 2; return st * 1024 + (ob ^ (((ob >> 9) & 1) << 5)); }
__host__ __device__ __forceinline__ void stage_rc(int b, int& R, int& C) { const int st = b / 1024, sb = b % 1024, swz = sb ^ (((sb >> 9) & 1) << 5); R = (st >> 1) * 16 + swz / 64; C = (st & 1) * 32 + (swz % 64) / 2; }
__host__ __device__ __forceinline__ int perm32(int rho) { const int n = rho >> 4, i = rho & 15; return 8 * (i >> 2) + 4 * n + (i & 3); }

struct Unit { int pm, pn; };
struct Gemm { const bf16_t* A; const bf16_t* Bt; int M, N, K; };

struct StaticOrder {
    int nM, nN, nwg, G, c;
    __host__ __device__ void init(int M, int N, int G_, int c_) { nM = M / BM; nN = N / BM; nwg = nM * nN; G = G_; c = c_; }
    __host__ __device__ bool next(int i, Unit& u) const {
        const long L = (long)i * G + c; if (L >= nwg) return false;
        int wgid = (int)L; { const int q = nwg / NXCD, r = nwg % NXCD, xcd = wgid % NXCD, off = wgid / NXCD; wgid = (xcd < r ? xcd * (q + 1) : r * (q + 1) + (xcd - r) * q) + off; }
        const int nig = WGM * nN, gid = wgid / nig, fm = gid * WGM, gsz = (nM - fm) < WGM ? (nM - fm) : WGM;
        u.pm = fm + ((wgid % nig) % gsz); u.pn = (wgid % nig) / gsz; return true;
    }
    __device__ __forceinline__ void a_ready(const Unit&) const {}
    __device__ __forceinline__ void done(const Unit&) const {}
};

__device__ __forceinline__ unsigned cvt_pk_bf16(float lo, float hi) { unsigned r; asm volatile("v_cvt_pk_bf16_f32 %0, %1, %2" : "=v"(r) : "v"(lo), "v"(hi)); return r; }
typedef float f32x2 __attribute__((ext_vector_type(2)));

struct EpiBf16B {
    static constexpr bool PERM = true, AFTER_DRAIN = false;
    bf16_t* O; int ldc; const float* bias; float sc;
    __device__ __forceinline__ void operator()(const f32x4 (&acc)[2][2][4][2], const Unit& u, int wr, int wc, int fr, int fq) const {
        const int row0 = u.pm * BM + wr * 64 + fr, col0 = u.pn * BM + wc * 32 + 8 * fq;
        f32x4 bv[2][2];
#pragma unroll
        for (int bj = 0; bj < 2; ++bj)
#pragma unroll
            for (int n = 0; n < 2; ++n) bv[bj][n] = bias ? *(const f32x4*)(bias + col0 + bj * HALF + 4 * n) : (f32x4){0.f, 0.f, 0.f, 0.f};
#pragma unroll
        for (int ai = 0; ai < 2; ++ai)
#pragma unroll
            for (int m = 0; m < 4; ++m) { bf16_t* rowp = O + (size_t)(row0 + ai * HALF + m * 16) * ldc + col0;
#pragma unroll
                for (int bj = 0; bj < 2; ++bj) { const f32x4 v0 = acc[ai][bj][m][0] * sc + bv[bj][0], v1 = acc[ai][bj][m][1] * sc + bv[bj][1];
                    u32x4 w; w.x = cvt_pk_bf16(v0[0], v0[1]); w.y = cvt_pk_bf16(v0[2], v0[3]); w.z = cvt_pk_bf16(v1[0], v1[1]); w.w = cvt_pk_bf16(v1[2], v1[3]);
                    *(u32x4*)(rowp + bj * HALF) = w; } }
    }
};
__device__ __forceinline__ float silu_mul(float g, float u) { const float e = __builtin_amdgcn_exp2f(g * -1.4426950408889634f); return g * __builtin_amdgcn_rcpf(1.0f + e) * u; }
struct EpiSwiGLU {
    static constexpr bool PERM = true, AFTER_DRAIN = false;
    bf16_t* H; int ldh;
    __device__ __forceinline__ void operator()(const f32x4 (&acc)[2][2][4][2], const Unit& u, int wr, int wc, int fr, int fq) const {
        const int row0 = u.pm * BM + wr * 64 + fr, col0 = u.pn * HALF + wc * 32 + 8 * fq;
#pragma unroll
        for (int ai = 0; ai < 2; ++ai)
#pragma unroll
            for (int m = 0; m < 4; ++m) { bf16_t* rowp = H + (size_t)(row0 + ai * HALF + m * 16) * ldh + col0;
                const f32x4 g0 = acc[ai][0][m][0], g1 = acc[ai][0][m][1], u0 = acc[ai][1][m][0], u1 = acc[ai][1][m][1];
                u32x4 w; w.x = cvt_pk_bf16(silu_mul(g0[0], u0[0]), silu_mul(g0[1], u0[1])); w.y = cvt_pk_bf16(silu_mul(g0[2], u0[2]), silu_mul(g0[3], u0[3]));
                w.z = cvt_pk_bf16(silu_mul(g1[0], u1[0]), silu_mul(g1[1], u1[1])); w.w = cvt_pk_bf16(silu_mul(g1[2], u1[2]), silu_mul(g1[3], u1[3]));
                *(u32x4*)rowp = w; }
    }
};
struct EpiResF32 {
    static constexpr bool PERM = false, AFTER_DRAIN = false;
    const float* base; float* out; int ldc; float alpha;
    __device__ __forceinline__ void operator()(const f32x4 (&acc)[2][2][4][2], const Unit& u, int wr, int wc, int fr, int fq) const {
        const int row0 = u.pm * BM + wr * 64 + fr, col0 = u.pn * BM + wc * 32 + 4 * fq;
#pragma unroll
        for (int ai = 0; ai < 2; ++ai)
#pragma unroll
            for (int m = 0; m < 4; ++m) { const size_t off = (size_t)(row0 + ai * HALF + m * 16) * ldc + col0;
                f32x4 bs[2][2];
#pragma unroll
                for (int bj = 0; bj < 2; ++bj)
#pragma unroll
                    for (int n = 0; n < 2; ++n) bs[bj][n] = *(const f32x4*)(base + off + bj * HALF + n * 16);
#pragma unroll
                for (int bj = 0; bj < 2; ++bj)
#pragma unroll
                    for (int n = 0; n < 2; ++n) *(f32x4*)(out + off + bj * HALF + n * 16) = bs[bj][n] + acc[ai][bj][m][n] * alpha;
                asm volatile("" ::: "memory"); }
    }
};

__device__ __forceinline__ float clamp448(float x) { return __builtin_fminf(__builtin_fmaxf(x, -448.f), 448.f); }
__device__ __forceinline__ unsigned pk4_fp8(float a, float b, float c, float d) {
    unsigned r = 0u; r = __builtin_amdgcn_cvt_pk_fp8_f32(clamp448(a), clamp448(b), r, false); r = __builtin_amdgcn_cvt_pk_fp8_f32(clamp448(c), clamp448(d), r, true); return r; }
typedef unsigned u32x2 __attribute__((ext_vector_type(2)));
struct EpiSwiGLUF8 {
    static constexpr bool PERM = true, AFTER_DRAIN = false;
    unsigned char* H; int ldh; float inv, hs;
    __device__ __forceinline__ void operator()(const f32x4 (&acc)[2][2][4][2], const Unit& u, int wr, int wc, int fr, int fq) const {
        const int row0 = u.pm * BM + wr * 64 + fr, col0 = u.pn * HALF + wc * 32 + 8 * fq;
#pragma unroll
        for (int ai = 0; ai < 2; ++ai)
#pragma unroll
            for (int m = 0; m < 4; ++m) { unsigned char* rowp = H + (size_t)(row0 + ai * HALF + m * 16) * ldh + col0;
                const f32x4 g0 = acc[ai][0][m][0] * inv, g1 = acc[ai][0][m][1] * inv, u0 = acc[ai][1][m][0] * (inv * hs), u1 = acc[ai][1][m][1] * (inv * hs);
                u32x2 w; w.x = pk4_fp8(silu_mul(g0[0], u0[0]), silu_mul(g0[1], u0[1]), silu_mul(g0[2], u0[2]), silu_mul(g0[3], u0[3]));
                w.y = pk4_fp8(silu_mul(g1[0], u1[0]), silu_mul(g1[1], u1[1]), silu_mul(g1[2], u1[2]), silu_mul(g1[3], u1[3]));
                *(u32x2*)rowp = w; }
    }
};

struct EpiProj {
    static constexpr bool PERM = true, AFTER_DRAIN = false;
    bf16_t* O; int ldc; const float* bias; float* ksum; int kcol0;
    __device__ __forceinline__ void operator()(const f32x4 (&acc)[2][2][4][2], const Unit& u, int wr, int wc, int fr, int fq) const {
        const int row0 = u.pm * BM + wr * 64 + fr, col0 = u.pn * BM + wc * 32 + 8 * fq;
        f32x4 bv[2][2];
#pragma unroll
        for (int bj = 0; bj < 2; ++bj)
#pragma unroll
            for (int n = 0; n < 2; ++n) bv[bj][n] = *(const f32x4*)(bias + col0 + bj * HALF + 4 * n);
#pragma unroll
        for (int ai = 0; ai < 2; ++ai)
#pragma unroll
            for (int m = 0; m < 4; ++m) { bf16_t* rowp = O + (size_t)(row0 + ai * HALF + m * 16) * ldc + col0;
#pragma unroll
                for (int bj = 0; bj < 2; ++bj) { const f32x4 v0 = acc[ai][bj][m][0] + bv[bj][0], v1 = acc[ai][bj][m][1] + bv[bj][1];
                    u32x4 w; w.x = cvt_pk_bf16(v0[0], v0[1]); w.y = cvt_pk_bf16(v0[2], v0[3]); w.z = cvt_pk_bf16(v1[0], v1[1]); w.w = cvt_pk_bf16(v1[2], v1[3]);
                    *(u32x4*)(rowp + bj * HALF) = w; } }
        const int kc = u.pn * BM - kcol0;
        if (kc >= 0 && kc < 2048) {
#pragma unroll
            for (int bj = 0; bj < 2; ++bj)
#pragma unroll
                for (int n = 0; n < 2; ++n) { f32x4 s = bv[bj][n] * 8.0f;
#pragma unroll
                    for (int ai = 0; ai < 2; ++ai)
#pragma unroll
                        for (int m = 0; m < 4; ++m) s = s + acc[ai][bj][m][n];
#pragma unroll
                    for (int jj = 0; jj < 4; ++jj) { float v = s[jj]; v += __shfl_xor(v, 1); v += __shfl_xor(v, 2); v += __shfl_xor(v, 4); v += __shfl_xor(v, 8); s[jj] = v; }
                    if (fr == 0) { const int c = kc + bj * HALF + wc * 32 + 8 * fq + 4 * n;
                        float* dst = ksum + ((size_t)u.pm * 16 + (c >> 7)) * 128 + (c & 127);
#pragma unroll
                        for (int jj = 0; jj < 4; ++jj) atomicAdd(dst + jj, s[jj]); } }
        }
    }
};
typedef int v4i_t __attribute__((ext_vector_type(4))); typedef int v8i_t __attribute__((ext_vector_type(8)));
__device__ __forceinline__ v8i_t cat8(bf16x8 a, bf16x8 b) { return __builtin_shufflevector(__builtin_bit_cast(v4i_t, a), __builtin_bit_cast(v4i_t, b), 0, 1, 2, 3, 4, 5, 6, 7); }
__device__ __forceinline__ void mfma_f8(f32x4& acc, v8i_t a, v8i_t b, int one) { asm volatile("v_mfma_scale_f32_16x16x128_f8f6f4 %0, %1, %2, %0, %3, %3 op_sel_hi:[0,0,0]" : "+v"(acc) : "v"(a), "v"(b), "v"(one)); }
template <class Epi, class Sched, bool ALIGN_EPI = false, bool SP2 = false, bool F8 = false>
__device__ __forceinline__ void gemm_phase(PG8_LAS unsigned char* lds, const Gemm g, const Sched& S, const Epi& E) {
    const int tid = threadIdx.x, wid = __builtin_amdgcn_readfirstlane(tid >> 6), lane = tid & 63, wr = wid >> 2, wc = wid & 3, fr = lane & 15, fq = lane >> 4;
    const int K = g.K, KB = F8 ? K : 2 * K  , nt = KB / (BK * 2);
    unsigned voffA[2], voffB[2];
#pragma unroll
    for (int i = 0; i < 2; ++i) { int R, C; stage_rc(tid * 16 + i * 8192, R, C); const int Rb = Epi::PERM ? ((R & ~31) + perm32(R & 31)) : R;
        voffA[i] = (unsigned)(R * KB + C * 2); voffB[i] = (unsigned)(Rb * KB + C * 2); }
    const size_t kstep = (size_t)(BK * 2);
    const size_t hstep = (size_t)HALF * KB;
    const size_t tstep = 2 * hstep;
    const unsigned ldsw = (unsigned)wid * 1024u;
    const int aoff = lds_byte(wr * 64 + fr, fq * 8), boff = lds_byte(wc * 32 + fr, fq * 8);
#define PG8_SA(b, h) (((b) * 2 + (h)) * HTB)
#define PG8_SB(b, h) ((4 + (b) * 2 + (h)) * HTB)
#define PG8_STAGE(bufoff, gbase, voff) do { _Pragma("unroll") for (int _i = 0; _i < 2; ++_i) \
        __builtin_amdgcn_global_load_lds((const unsigned*)((const char*)(gbase) + (voff)[_i]), (PG8_LAS unsigned*)(lds + (bufoff) + ldsw + _i * 8192), 16, 0, 0); } while (0)
#define PG8_LDA(dst, b, h) do { _Pragma("unroll") for (int m = 0; m < 4; ++m) _Pragma("unroll") for (int k = 0; k < 2; ++k) dst[m][k] = *(const PG8_LAS bf16x8*)(lds + PG8_SA(b, h) + aoff + m * 2048 + k * 1024); } while (0)
#define PG8_LDB(dst, b, h) do { _Pragma("unroll") for (int n = 0; n < 2; ++n) _Pragma("unroll") for (int k = 0; k < 2; ++k) dst[n][k] = *(const PG8_LAS bf16x8*)(lds + PG8_SB(b, h) + boff + n * 2048 + k * 1024); } while (0)
#define PG8_MMA(ai, bj, At, Bt) do { __builtin_amdgcn_s_setprio(1); _Pragma("unroll") for (int m = 0; m < 4; ++m) _Pragma("unroll") for (int n = 0; n < 2; ++n) { \
        if constexpr (F8) mfma_f8(acc[ai][bj][m][n], cat8(Bt[n][0], Bt[n][1]), cat8(At[m][0], At[m][1]), f8_one); \
        else { _Pragma("unroll") for (int k = 0; k < 2; ++k) acc[ai][bj][m][n] = __builtin_amdgcn_mfma_f32_16x16x32_bf16(Bt[n][k], At[m][k], acc[ai][bj][m][n], 0, 0, 0); } } \
        __builtin_amdgcn_s_setprio(0); } while (0)
#define PG8_WAIT_V(n) asm volatile("s_waitcnt vmcnt(" #n ")" ::: "memory")
#define PG8_WAIT_L(n) asm volatile("s_waitcnt lgkmcnt(" #n ")" ::: "memory")
#define PG8_BAR __builtin_amdgcn_s_barrier()
#define PG8_SCHED __builtin_amdgcn_sched_barrier(0)
    Unit cur, nxt; int ui = 0;
    int f8_one = 0x7f7f7f7f; if constexpr (F8) asm volatile("" : "+v"(f8_one));
    if (!S.next(0, cur)) return;
    f32x4 acc[2][2][4][2];
#pragma unroll
    for (int a = 0; a < 2; ++a)
#pragma unroll
        for (int b = 0; b < 2; ++b)
#pragma unroll
            for (int m = 0; m < 4; ++m)
#pragma unroll
                for (int n = 0; n < 2; ++n) acc[a][b][m][n] = (f32x4){0.f, 0.f, 0.f, 0.f};
    bf16x8 At[4][2], B0[2][2], B1[2][2];
    const char* cA = (const char*)g.A + (size_t)cur.pm * tstep; const char* cB = (const char*)g.Bt + (size_t)cur.pn * tstep;
    S.a_ready(cur);
    if constexpr (SP2) {
        PG8_STAGE(PG8_SB(0, 0), cB, voffB); PG8_STAGE(PG8_SB(0, 1), cB + hstep, voffB); PG8_STAGE(PG8_SA(0, 0), cA, voffA); PG8_STAGE(PG8_SA(0, 1), cA + hstep, voffA);
        if (wr == 1) PG8_BAR;
        PG8_WAIT_V(2); PG8_BAR;
        PG8_STAGE(PG8_SB(1, 0), cB + kstep, voffB); PG8_STAGE(PG8_SA(1, 0), cA + kstep, voffA); PG8_STAGE(PG8_SB(1, 1), cB + hstep + kstep, voffB);
        PG8_WAIT_V(6); PG8_BAR;
    } else {
        PG8_STAGE(PG8_SB(0, 0), cB, voffB); PG8_STAGE(PG8_SA(0, 0), cA, voffA); PG8_STAGE(PG8_SB(0, 1), cB + hstep, voffB); PG8_STAGE(PG8_SA(0, 1), cA + hstep, voffA);
        if (wr == 1) PG8_BAR;
        PG8_WAIT_V(4); PG8_BAR;
        PG8_STAGE(PG8_SB(1, 0), cB + kstep, voffB); PG8_STAGE(PG8_SA(1, 0), cA + kstep, voffA); PG8_STAGE(PG8_SB(1, 1), cB + hstep + kstep, voffB);
        PG8_WAIT_V(6); PG8_BAR;
    }
    for (;;) {
        const bool has_next = S.next(ui + 1, nxt);
        const char* nA = has_next ? (const char*)g.A + (size_t)nxt.pm * tstep : cA; const char* nB = has_next ? (const char*)g.Bt + (size_t)nxt.pn * tstep : cB;
        for (int t = 0; t < nt; t += 2) {
            const bool last = (t == nt - 2);
            const char* a1 = cA + (size_t)(t + 1) * kstep;
            const char* a2 = last ? nA : cA + (size_t)(t + 2) * kstep; const char* b2 = last ? nB : cB + (size_t)(t + 2) * kstep;
            const char* a3 = a2 + kstep; const char* b3 = b2 + kstep;
            if (last && has_next) S.a_ready(nxt);
            if constexpr (SP2) {
            PG8_LDB(B0, 0, 0); PG8_LDB(B1, 0, 1); PG8_SCHED; PG8_LDA(At, 0, 0); PG8_STAGE(PG8_SA(1, 1), a1 + hstep, voffA);
            PG8_WAIT_V(8); PG8_WAIT_L(0); PG8_BAR; PG8_MMA(0, 0, At, B0); PG8_MMA(0, 1, At, B1); PG8_BAR; PG8_SCHED;
            PG8_LDA(At, 0, 1); PG8_STAGE(PG8_SB(0, 0), b2, voffB); PG8_STAGE(PG8_SB(0, 1), b2 + hstep, voffB); PG8_STAGE(PG8_SA(0, 0), a2, voffA);
            PG8_WAIT_V(8); PG8_WAIT_L(0); PG8_BAR; PG8_MMA(1, 0, At, B0); PG8_MMA(1, 1, At, B1); PG8_BAR; PG8_SCHED;
            PG8_LDB(B0, 1, 0); PG8_LDB(B1, 1, 1); PG8_SCHED; PG8_LDA(At, 1, 0); PG8_STAGE(PG8_SA(0, 1), a2 + hstep, voffA);
            PG8_WAIT_V(8); PG8_WAIT_L(0); PG8_BAR; PG8_MMA(0, 0, At, B0); PG8_MMA(0, 1, At, B1); PG8_BAR; PG8_SCHED;
            PG8_LDA(At, 1, 1); PG8_STAGE(PG8_SB(1, 0), b3, voffB); PG8_STAGE(PG8_SB(1, 1), b3 + hstep, voffB); PG8_STAGE(PG8_SA(1, 0), a3, voffA);
            PG8_WAIT_V(8); PG8_WAIT_L(0); PG8_BAR; PG8_MMA(1, 0, At, B0); PG8_MMA(1, 1, At, B1); PG8_BAR; PG8_SCHED;
            } else {
            PG8_LDB(B0, 0, 0); PG8_SCHED; PG8_LDA(At, 0, 0); PG8_STAGE(PG8_SA(1, 1), a1 + hstep, voffA);
            PG8_WAIT_L(8); PG8_BAR; PG8_WAIT_L(0); PG8_MMA(0, 0, At, B0); PG8_BAR; PG8_SCHED;
            PG8_LDB(B1, 0, 1); PG8_STAGE(PG8_SB(0, 0), b2, voffB);
            PG8_BAR; PG8_WAIT_L(0); PG8_MMA(0, 1, At, B1); PG8_BAR;
            PG8_LDA(At, 0, 1); PG8_STAGE(PG8_SA(0, 0), a2, voffA);
            PG8_BAR; PG8_WAIT_L(0); PG8_MMA(1, 0, At, B0); PG8_BAR; PG8_SCHED;
            PG8_STAGE(PG8_SB(0, 1), b2 + hstep, voffB);
            PG8_WAIT_V(6); PG8_BAR; PG8_MMA(1, 1, At, B1); PG8_BAR;
            PG8_LDB(B0, 1, 0); PG8_SCHED; PG8_LDA(At, 1, 0); PG8_STAGE(PG8_SA(0, 1), a2 + hstep, voffA);
            PG8_WAIT_L(8); PG8_BAR; PG8_WAIT_L(0); PG8_MMA(0, 0, At, B0); PG8_BAR; PG8_SCHED;
            PG8_LDB(B1, 1, 1); PG8_STAGE(PG8_SB(1, 0), b3, voffB);
            PG8_BAR; PG8_WAIT_L(0); PG8_MMA(0, 1, At, B1); PG8_BAR;
            PG8_LDA(At, 1, 1); PG8_STAGE(PG8_SA(1, 0), a3, voffA);
            PG8_BAR; PG8_WAIT_L(0); PG8_MMA(1, 0, At, B0); PG8_BAR; PG8_SCHED;
            PG8_STAGE(PG8_SB(1, 1), b3 + hstep, voffB);
            PG8_WAIT_V(6); PG8_BAR; PG8_MMA(1, 1, At, B1); PG8_BAR;
            }
        }
        if constexpr (ALIGN_EPI) { if (wr == 0) PG8_BAR; }
        if constexpr (!Epi::AFTER_DRAIN) { E(acc, cur, wr, wc, fr, fq); S.done(cur); }
        if (!has_next) break;
#pragma unroll
        for (int a = 0; a < 2; ++a)
#pragma unroll
            for (int b = 0; b < 2; ++b)
#pragma unroll
                for (int m = 0; m < 4; ++m)
#pragma unroll
                    for (int n = 0; n < 2; ++n) acc[a][b][m][n] = (f32x4){0.f, 0.f, 0.f, 0.f};
        cur = nxt; cA = nA; cB = nB; ++ui;
        if constexpr (ALIGN_EPI) { if (wr == 1) PG8_BAR; }
    }
    PG8_WAIT_V(0);
    if constexpr (!ALIGN_EPI) { if (wr == 0) PG8_BAR; }
    PG8_BAR;
    if constexpr (Epi::AFTER_DRAIN) { E.fused(acc, cur, wr, wc, fr, fq, lds, wid, lane); S.done(cur); }
#undef PG8_SA
#undef PG8_SB
#undef PG8_STAGE
#undef PG8_LDA
#undef PG8_LDB
#undef PG8_MMA
#undef PG8_WAIT_V
#undef PG8_WAIT_L
#undef PG8_BAR
#undef PG8_SCHED
}
}

constexpr int NB = 4, SEQ = 4096, DM = 4096, FF = 11008, M = NB * SEQ;
constexpr int HD = 128, NHM = 16, NHS = 16, NKVS = 4, NMEM = 256, NHC = 4;
constexpr int MOBA_W = 2048, SWA_W = 2048, SWA_KV_W = 512, CROSS_W = 512, IN_W = 9216;
constexpr int COL_QM = 0, COL_KM = 2048, COL_VM = 4096, COL_QS = 6144, COL_KS = 8192, COL_VS = 8704;
constexpr float EPS = 1e-6f;
constexpr float LOG2E = 1.4426950408889634f;
constexpr float QK_C = 0.088388347648318440f * 1.4426950408889634f;
constexpr int NWAVES = 8;

constexpr size_t MiB = 1u << 20;
constexpr size_t WS_CTL = 0, CTL_ZERO_BYTES = 2 * MiB;
constexpr size_t WS_KMEAN = 1 * MiB;
constexpr size_t WS_KVC = 2 * MiB;
constexpr size_t WS_MEMN = 4 * MiB;
constexpr size_t WS_QC = 12 * MiB;
constexpr size_t WS_OC = 28 * MiB;
constexpr size_t WS_WCQ = 44 * MiB;
constexpr size_t WS_WCKV = 48 * MiB;
constexpr size_t WS_WCO = 56 * MiB;
constexpr size_t WS_WOUT = 60 * MiB;
constexpr size_t WS_WIN = 92 * MiB;
constexpr size_t WS_WGU1 = 164 * MiB;
constexpr size_t WS_WD1 = 336 * MiB;
constexpr size_t WS_WGU2 = 422 * MiB;
constexpr size_t WS_WD2 = 594 * MiB;
constexpr size_t WS_N = 680 * MiB;
constexpr size_t WS_H = 808 * MiB;
constexpr size_t WS_END = 1152 * MiB;
constexpr int CW_BAR = 4096;

constexpr int RING_OFF = 0, RING_BYTES = 131072;
constexpr int LDSCTL_OFF = RING_BYTES, MISC_OFF = LDSCTL_OFF + 320;
constexpr int LDS_BYTES = 147456;

#define GAS __attribute__((address_space(1)))
#define LAS __attribute__((address_space(3)))
typedef unsigned short bf16;
typedef unsigned v4u __attribute__((ext_vector_type(4)));
typedef unsigned v2u __attribute__((ext_vector_type(2)));
typedef float f32x4 __attribute__((ext_vector_type(4)));
typedef short bf16x8 __attribute__((ext_vector_type(8)));
typedef short s16x4 __attribute__((ext_vector_type(4)));
typedef GAS unsigned gu32;
#define RLX_AGENT __ATOMIC_RELAXED, __HIP_MEMORY_SCOPE_AGENT
#define LDS_WAIT() asm volatile("s_waitcnt lgkmcnt(0)" ::: "memory")
#define VM_WAIT() asm volatile("s_waitcnt vmcnt(0)" ::: "memory")
__device__ __forceinline__ unsigned f2bf(float f) { unsigned u = __builtin_bit_cast(unsigned, f); return (u + 0x7fffu + ((u >> 16) & 1u)) >> 16; }
__device__ __forceinline__ unsigned pk2(float lo, float hi) { return f2bf(lo) | (f2bf(hi) << 16); }
__device__ __forceinline__ float bf_lo(unsigned w) { return __builtin_bit_cast(float, w << 16); }
__device__ __forceinline__ float bf_hi(unsigned w) { return __builtin_bit_cast(float, w & 0xffff0000u); }
#define XB_TMO      128
#define XB_XCNT(j)  (256  + 64 * (j))
#define XB_XSUB(j)  (1280 + 64 * (j))
#define XB_XGEN(j)  (2304 + 64 * (j))
#define XB_TOP      3328
#define XB_TOPGEN   3392
#define XCD_BAR_WORDS 3456
#define XB_SPIN_CAP (1u << 18)

__device__ __forceinline__ unsigned xb_ld(unsigned* p)              { return __hip_atomic_load(p, __ATOMIC_RELAXED, __HIP_MEMORY_SCOPE_AGENT); }
__device__ __forceinline__ unsigned xb_add(unsigned* p, unsigned v) { return __hip_atomic_fetch_add(p, v, __ATOMIC_RELAXED, __HIP_MEMORY_SCOPE_AGENT); }
__device__ __forceinline__ unsigned xb_xcc_id() { return (unsigned)__builtin_amdgcn_s_getreg((3 << 11) | 20) & 0xFu; }
#define XB_SPIN(cond, bar) do { unsigned _sp = 0; while (cond) { __builtin_amdgcn_s_sleep(1); \
    if ((++_sp & 255u) == 0u) { if (xb_ld(&(bar)[XB_TMO])) break; if (_sp > XB_SPIN_CAP) { atomicAdd(&(bar)[XB_TMO], 1u); break; } } } } while (0)

struct XcdBarrier {
    unsigned* bar; unsigned x;
    volatile LAS unsigned* st;
};

__device__ __forceinline__ XcdBarrier xcd_barrier_post(unsigned* bar, volatile LAS unsigned* st) {
    XcdBarrier b; b.bar = bar; b.x = xb_xcc_id(); b.st = st;
    if (threadIdx.x == 0) (void)xb_add(&bar[XB_XCNT(b.x)], 1u);
    return b;
}
__device__ __forceinline__ void xcd_barrier_complete(unsigned* bar, unsigned x, unsigned& nloc, unsigned& nx) {
    const unsigned G = gridDim.x * gridDim.y * gridDim.z;
    unsigned sum, cnt, mine, sp = 0u;
    for (;;) {
        sum = 0u; cnt = 0u; mine = 0u;
#pragma unroll
        for (unsigned j = 0; j < 16; ++j) { const unsigned c = xb_ld(&bar[XB_XCNT(j)]); sum += c; cnt += (c > 0u) ? 1u : 0u; mine = (j == x) ? c : mine; }
        if (sum == G) break;
        __builtin_amdgcn_s_sleep(1);
        if ((++sp & 255u) == 0u) { if (xb_ld(&bar[XB_TMO])) break; if (sp > XB_SPIN_CAP) { atomicAdd(&bar[XB_TMO], 1u); break; } }
    }
    nloc = mine > 0u ? mine : 1u; nx = cnt > 0u ? cnt : 1u;
}

__device__ __forceinline__ void xcd_barrier(const XcdBarrier& b) {
    asm volatile("s_waitcnt vmcnt(0)" ::: "memory");
    __syncthreads();
    if (threadIdx.x == 0) {
        unsigned* bar = b.bar;
        __builtin_amdgcn_s_waitcnt(0);
        unsigned nloc = b.st[0], nx = b.st[1];
        if (nloc == 0u) { xcd_barrier_complete(bar, b.x, nloc, nx); b.st[0] = nloc; b.st[1] = nx; }
        const unsigned old = xb_add(&bar[XB_XSUB(b.x)], 1u);
        const unsigned gen = old / nloc;
        if (old + 1u == (gen + 1u) * nloc) {
            __builtin_amdgcn_fence(__ATOMIC_RELEASE, "agent");
            asm volatile("s_waitcnt vmcnt(0)" ::: "memory");
            const unsigned og = xb_add(&bar[XB_TOP], 1u);
            const unsigned tg = og / nx;
            if (og + 1u == (tg + 1u) * nx) xb_add(&bar[XB_TOPGEN], 1u);
            else XB_SPIN(xb_ld(&bar[XB_TOPGEN]) == tg, bar);
            __builtin_amdgcn_fence(__ATOMIC_ACQUIRE, "agent");
            xb_add(&bar[XB_XGEN(b.x)], 1u);
            asm volatile("s_waitcnt vmcnt(0)" ::: "memory");
        } else {
            XB_SPIN(xb_ld(&bar[XB_XGEN(b.x)]) == gen, bar);
            __builtin_amdgcn_fence(__ATOMIC_ACQUIRE, "agent");
            asm volatile("s_waitcnt vmcnt(0)" ::: "memory");
        }
    }
    __syncthreads();
}

__device__ __forceinline__ float wave_sum(float v) {
#pragma unroll
    for (int o = 1; o < 64; o <<= 1) v += __shfl_xor(v, o);
    return v;
}
__device__ __forceinline__ void cvt_item(const float* W, int K, int N, bf16* WT, int grp, int gstride, int goff, LAS float* scr, int item, int lane) {
    const int nblk = N / 32, kb = item / nblk, nb = item % nblk, k0 = 64 * kb, n0 = 32 * nb;
    const int orow0 = (n0 / grp) * gstride + goff + (n0 % grp);
#pragma unroll 4
    for (int i = 0; i < 32; ++i) { const int kk = 2 * i + (lane >> 5); scr[kk * 33 + (lane & 31)] = W[(size_t)(k0 + kk) * N + n0 + (lane & 31)]; }
    LDS_WAIT(); asm volatile("" ::: "memory");
    const int c = lane & 7;
#pragma unroll
    for (int j = 0; j < 4; ++j) { const int n = (lane >> 3) + 8 * j; const LAS float* s = scr + (8 * c) * 33 + n;
        v4u o; o.x = pk2(s[0 * 33], s[1 * 33]); o.y = pk2(s[2 * 33], s[3 * 33]); o.z = pk2(s[4 * 33], s[5 * 33]); o.w = pk2(s[6 * 33], s[7 * 33]);
        *(v4u*)(WT + (size_t)(orow0 + n) * K + k0 + 8 * c) = o; }
    LDS_WAIT(); asm volatile("" ::: "memory");
}
__device__ __forceinline__ void rms_row_bf16(const float* xrow, const float* g, bf16* orow, int lane) {
    const f32x4* xr = (const f32x4*)xrow + lane;
    f32x4 v[16]; float s = 0.f;
#pragma unroll
    for (int j = 0; j < 16; ++j) { v[j] = xr[64 * j]; s += (v[j].x * v[j].x + v[j].y * v[j].y) + (v[j].z * v[j].z + v[j].w * v[j].w); }
    const float rstd = 1.0f / sqrtf(wave_sum(s) * (1.f / DM) + EPS);
    const f32x4* gr = (const f32x4*)g + lane;
    v2u* o8 = (v2u*)orow + lane;
#pragma unroll
    for (int j = 0; j < 16; ++j) { const f32x4 gg = gr[64 * j]; v2u w; w.x = pk2(v[j].x * rstd * gg.x, v[j].y * rstd * gg.y); w.y = pk2(v[j].z * rstd * gg.z, v[j].w * rstd * gg.w); o8[64 * j] = w; }
}
__device__ __forceinline__ void cvt_item_f8(const float* W, int K, int N, unsigned char* WT, int grp, int gstride, int goff, float scale, LAS float* scr, int item, int lane) {
    const int nblk = N / 32, kb = item / nblk, nb = item % nblk, k0 = 64 * kb, n0 = 32 * nb;
    const int orow0 = (n0 / grp) * gstride + goff + (n0 % grp);
#pragma unroll 4
    for (int i = 0; i < 32; ++i) { const int kk = 2 * i + (lane >> 5); scr[kk * 33 + (lane & 31)] = W[(size_t)(k0 + kk) * N + n0 + (lane & 31)]; }
    LDS_WAIT(); asm volatile("" ::: "memory");
    const int c = lane & 3;
#pragma unroll
    for (int j = 0; j < 2; ++j) { const int n = (lane >> 2) + 16 * j; const LAS float* s = scr + (16 * c) * 33 + n;
        v4u o;
        o.x = pg8::pk4_fp8(s[0 * 33] * scale, s[1 * 33] * scale, s[2 * 33] * scale, s[3 * 33] * scale); o.y = pg8::pk4_fp8(s[4 * 33] * scale, s[5 * 33] * scale, s[6 * 33] * scale, s[7 * 33] * scale);
        o.z = pg8::pk4_fp8(s[8 * 33] * scale, s[9 * 33] * scale, s[10 * 33] * scale, s[11 * 33] * scale); o.w = pg8::pk4_fp8(s[12 * 33] * scale, s[13 * 33] * scale, s[14 * 33] * scale, s[15 * 33] * scale);
        *(v4u*)(WT + (size_t)(orow0 + n) * K + k0 + 16 * c) = o; }
    LDS_WAIT(); asm volatile("" ::: "memory");
}
__device__ __forceinline__ void rms_row_f8(const float* xrow, const float* g, unsigned char* orow, int lane) {
    const f32x4* xr = (const f32x4*)xrow + lane;
    f32x4 v[16]; float s = 0.f;
#pragma unroll
    for (int j = 0; j < 16; ++j) { v[j] = xr[64 * j]; s += (v[j].x * v[j].x + v[j].y * v[j].y) + (v[j].z * v[j].z + v[j].w * v[j].w); }
    const float rstd = 1.0f / sqrtf(wave_sum(s) * (1.f / DM) + EPS);
    const f32x4* gr = (const f32x4*)g + lane;
    unsigned* o4 = (unsigned*)orow + lane;
#pragma unroll
    for (int j = 0; j < 16; ++j) { const f32x4 gg = gr[64 * j]; o4[64 * j] = pg8::pk4_fp8(v[j].x * rstd * gg.x, v[j].y * rstd * gg.y, v[j].z * rstd * gg.z, v[j].w * rstd * gg.w); }
}
__device__ __forceinline__ void rms_row_f32(float* xrow, const float* g, int lane) {
    f32x4* xr = (f32x4*)xrow + lane;
    f32x4 v[16]; float s = 0.f;
#pragma unroll
    for (int j = 0; j < 16; ++j) { v[j] = xr[64 * j]; s += (v[j].x * v[j].x + v[j].y * v[j].y) + (v[j].z * v[j].z + v[j].w * v[j].w); }
    const float rstd = 1.0f / sqrtf(wave_sum(s) * (1.f / DM) + EPS);
    const f32x4* gr = (const f32x4*)g + lane;
#pragma unroll
    for (int j = 0; j < 16; ++j) { const f32x4 gg = gr[64 * j]; xr[64 * j] = v[j] * rstd * gg; }
}
__device__ __forceinline__ void onorm_row(bf16* orow, const float* gm, const float* gs, int lane) {
    const int half = lane >> 5, l32 = lane & 31;
    v4u* p = (v4u*)(orow + half * 2048) + l32;
    v4u v[8]; float s = 0.f;
#pragma unroll
    for (int j = 0; j < 8; ++j) { v[j] = p[32 * j];
#pragma unroll
        for (int e = 0; e < 4; ++e) { const float a = bf_lo(v[j][e]), b = bf_hi(v[j][e]); s += a * a + b * b; } }
#pragma unroll
    for (int o = 1; o < 32; o <<= 1) s += __shfl_xor(s, o);
    const float rstd = 1.0f / sqrtf(s * (1.f / 2048.f) + EPS);
    const float* g = half ? gs : gm;
#pragma unroll
    for (int j = 0; j < 8; ++j) { const f32x4* gp = (const f32x4*)(g + (l32 + 32 * j) * 8); const f32x4 g0 = gp[0], g1 = gp[1]; v4u w;
        w.x = pk2(bf_lo(v[j].x) * rstd * g0.x, bf_hi(v[j].x) * rstd * g0.y); w.y = pk2(bf_lo(v[j].y) * rstd * g0.z, bf_hi(v[j].y) * rstd * g0.w);
        w.z = pk2(bf_lo(v[j].z) * rstd * g1.x, bf_hi(v[j].z) * rstd * g1.y); w.w = pk2(bf_lo(v[j].w) * rstd * g1.z, bf_hi(v[j].w) * rstd * g1.w);
        p[32 * j] = w; }
}
__device__ __forceinline__ void onorm_row_f8(const bf16* orow, unsigned char* orow8, const float* gm, const float* gs, int lane) {
    const int half = lane >> 5, l32 = lane & 31;
    const v4u* p = (const v4u*)(orow + half * 2048) + l32;
    v4u v[8]; float s = 0.f;
#pragma unroll
    for (int j = 0; j < 8; ++j) { v[j] = p[32 * j];
#pragma unroll
        for (int e = 0; e < 4; ++e) { const float a = bf_lo(v[j][e]), b = bf_hi(v[j][e]); s += a * a + b * b; } }
#pragma unroll
    for (int o = 1; o < 32; o <<= 1) s += __shfl_xor(s, o);
    const float rstd = 1.0f / sqrtf(s * (1.f / 2048.f) + EPS);
    const float* g = half ? gs : gm;
    asm volatile("s_waitcnt vmcnt(0)" ::: "memory");
    v2u* q = (v2u*)(orow8 + half * 2048) + l32;
#pragma unroll
    for (int j = 0; j < 8; ++j) { const f32x4* gp = (const f32x4*)(g + (l32 + 32 * j) * 8); const f32x4 g0 = gp[0], g1 = gp[1]; v2u w;
        w.x = pg8::pk4_fp8(bf_lo(v[j].x) * rstd * g0.x, bf_hi(v[j].x) * rstd * g0.y, bf_lo(v[j].y) * rstd * g0.z, bf_hi(v[j].y) * rstd * g0.w);
        w.y = pg8::pk4_fp8(bf_lo(v[j].z) * rstd * g1.x, bf_hi(v[j].z) * rstd * g1.y, bf_lo(v[j].w) * rstd * g1.z, bf_hi(v[j].w) * rstd * g1.w);
        q[32 * j] = w; }
}

namespace att {
constexpr int KST = 272, VST = 288;
constexpr int K_OFF = 0, V_OFF = 64 * KST, TILE_BYTES = V_OFF + 64 * VST  , KM_OFF = 2 * TILE_BYTES, LUT_OFF = KM_OFF + 16 * 128 * 4, LUT_STRIDE = 132  , RED_OFF = LUT_OFF + 2 * LUT_STRIDE * 4, END_OFF = RED_OFF + 8 * 128 * 4;
constexpr float SM_THR = 8.f;
static_assert(END_OFF <= RING_BYTES && V_OFF % 16 == 0 && KM_OFF % 16 == 0 && TILE_BYTES % 16 == 0, "attention LDS map");

__device__ __forceinline__ int t5_bucket(int n) {
    if (n < 16) return n;
    return 16 + (n >= 19) + (n >= 21) + (n >= 24) + (n >= 27) + (n >= 31) + (n >= 35) + (n >= 40) + (n >= 46) + (n >= 52) + (n >= 59) + (n >= 67) + (n >= 77) + (n >= 87) + (n >= 99) + (n >= 113);
}
__device__ __forceinline__ float bf2f(short s) { return __builtin_bit_cast(float, ((unsigned)(unsigned short)s) << 16); }

__device__ __forceinline__ void kv_load(const bf16* Kg, const bf16* Vg, int ld, int tid, v4u (&kr)[2], v4u (&vr)[2]) {
#pragma unroll
    for (int i = 0; i < 2; ++i) { const int c = tid + 512 * i, row = c >> 4, col = (c & 15) * 8;
        kr[i] = *(const v4u*)(Kg + (size_t)row * ld + col); vr[i] = *(const v4u*)(Vg + (size_t)row * ld + col); }
}
__device__ __forceinline__ void kv_store(LAS unsigned char* L, int tid, const v4u (&kr)[2], const v4u (&vr)[2]) {
#pragma unroll
    for (int i = 0; i < 2; ++i) { const int c = tid + 512 * i, row = c >> 4, cb = (c & 15) * 16;
        *(LAS v4u*)(L + K_OFF + row * KST + cb) = kr[i]; *(LAS v4u*)(L + V_OFF + row * VST + cb) = vr[i]; }
}
__device__ __forceinline__ void q_load(const bf16* Qp, int ldq, int row0, int j, int g, bf16x8 (&qf)[2][4]) {
#pragma unroll
    for (int qg = 0; qg < 2; ++qg)
#pragma unroll
        for (int dd = 0; dd < 4; ++dd) qf[qg][dd] = *(const bf16x8*)(Qp + (size_t)(row0 + 16 * qg + j) * ldq + 32 * dd + 8 * g);
}
__device__ __forceinline__ void qk_tile(LAS unsigned char* L, const bf16x8 (&qf)[2][4], f32x4 (&t)[2][4], int j, int g) {
    const LAS unsigned char* base = L + K_OFF + j * KST + g * 16;
    bf16x8 kf[2][4];
#pragma unroll
    for (int dd = 0; dd < 4; ++dd) kf[0][dd] = *(const LAS bf16x8*)(base + dd * 64);
#pragma unroll
    for (int ks = 0; ks < 4; ++ks) {
        if (ks + 1 < 4) {
#pragma unroll
            for (int dd = 0; dd < 4; ++dd) kf[(ks + 1) & 1][dd] = *(const LAS bf16x8*)(base + (ks + 1) * 16 * KST + dd * 64); }
        __builtin_amdgcn_sched_barrier(0);
        __builtin_amdgcn_s_setprio(2);
        t[0][ks] = (f32x4){0.f, 0.f, 0.f, 0.f}; t[1][ks] = (f32x4){0.f, 0.f, 0.f, 0.f};
#pragma unroll
        for (int dd = 0; dd < 4; ++dd) {
            t[0][ks] = __builtin_amdgcn_mfma_f32_16x16x32_bf16(kf[ks & 1][dd], qf[0][dd], t[0][ks], 0, 0, 0);
            t[1][ks] = __builtin_amdgcn_mfma_f32_16x16x32_bf16(kf[ks & 1][dd], qf[1][dd], t[1][ks], 0, 0, 0); }
        __builtin_amdgcn_s_setprio(0);
        __builtin_amdgcn_sched_barrier(0); }
}
__device__ __forceinline__ void pv_tile(LAS unsigned char* L, const bf16x8 (&pf)[2][2], f32x4 (&o)[2][8], int lane) {
    const int g = lane >> 4, q_ = (lane & 15) >> 2, p_ = lane & 3;
    LAS unsigned char* base = L + V_OFF + (4 * g + q_) * VST + p_ * 8;
    s16x4 lo[2][2], hi[2][2];
#define PV_LOAD(buf, grp) do { _Pragma("unroll") for (int e = 0; e < 2; ++e) { const int kk_ = (grp) >> 2, ds_ = 2 * ((grp) & 3) + e; \
        lo[buf][e] = __builtin_amdgcn_ds_read_tr16_b64_v4i16((LAS s16x4*)(base + (32 * kk_) * VST + ds_ * 32)); \
        hi[buf][e] = __builtin_amdgcn_ds_read_tr16_b64_v4i16((LAS s16x4*)(base + (32 * kk_ + 16) * VST + ds_ * 32)); } } while (0)
    PV_LOAD(0, 0);
#pragma unroll
    for (int grp = 0; grp < 8; ++grp) {
        if (grp + 1 < 8) PV_LOAD((grp + 1) & 1, grp + 1);
        __builtin_amdgcn_sched_barrier(0);
        __builtin_amdgcn_s_setprio(2);
#pragma unroll
        for (int e = 0; e < 2; ++e) { const int kk = grp >> 2, ds = 2 * (grp & 3) + e; const s16x4 a = lo[grp & 1][e], c = hi[grp & 1][e];
            const bf16x8 vf = (bf16x8){a[0], a[1], a[2], a[3], c[0], c[1], c[2], c[3]};
            o[0][ds] = __builtin_amdgcn_mfma_f32_16x16x32_bf16(vf, pf[0][kk], o[0][ds], 0, 0, 0);
            o[1][ds] = __builtin_amdgcn_mfma_f32_16x16x32_bf16(vf, pf[1][kk], o[1][ds], 0, 0, 0); }
        __builtin_amdgcn_s_setprio(0);
        __builtin_amdgcn_sched_barrier(0); }
#undef PV_LOAD
}
__device__ __forceinline__ void sm_update(f32x4 (&t)[2][4], float (&m)[2], float (&l)[2], f32x4 (&o)[2][8], bf16x8 (&pf)[2][2]) {
    float mx[2];
#pragma unroll
    for (int qg = 0; qg < 2; ++qg) { float v = -INFINITY;
#pragma unroll
        for (int ks = 0; ks < 4; ++ks)
#pragma unroll
            for (int r = 0; r < 4; ++r) v = fmaxf(v, t[qg][ks][r]);
        v = fmaxf(v, __shfl_xor(v, 16)); v = fmaxf(v, __shfl_xor(v, 32)); mx[qg] = v; }
    const bool grow = (mx[0] > m[0] + SM_THR) || (mx[1] > m[1] + SM_THR);
    if (__any((int)grow)) {
#pragma unroll
        for (int qg = 0; qg < 2; ++qg) { const float mn = fmaxf(m[qg], mx[qg]); const float mref = (mn == -INFINITY) ? 0.f : mn;
            const float alpha = __builtin_amdgcn_exp2f(m[qg] - mref); l[qg] *= alpha; m[qg] = mn;
#pragma unroll
            for (int ds = 0; ds < 8; ++ds) o[qg][ds] = o[qg][ds] * alpha; }
    }
#pragma unroll
    for (int qg = 0; qg < 2; ++qg) { const float mref = (m[qg] == -INFINITY) ? 0.f : m[qg]; float ps = 0.f;
#pragma unroll
        for (int ks = 0; ks < 4; ++ks)
#pragma unroll
            for (int r = 0; r < 4; ++r) { const float p = __builtin_amdgcn_exp2f(t[qg][ks][r] - mref); t[qg][ks][r] = p; ps += p; }
        l[qg] += ps;
#pragma unroll
        for (int kk = 0; kk < 2; ++kk) { v4u w;
            w.x = pg8::cvt_pk_bf16(t[qg][2 * kk][0], t[qg][2 * kk][1]); w.y = pg8::cvt_pk_bf16(t[qg][2 * kk][2], t[qg][2 * kk][3]);
            w.z = pg8::cvt_pk_bf16(t[qg][2 * kk + 1][0], t[qg][2 * kk + 1][1]); w.w = pg8::cvt_pk_bf16(t[qg][2 * kk + 1][2], t[qg][2 * kk + 1][3]);
            pf[qg][kk] = __builtin_bit_cast(bf16x8, w); }
    }
}
__device__ __forceinline__ void o_store(bf16* Op, int ldo, int row0, float (&l)[2], f32x4 (&o)[2][8], int j, int g) {
#pragma unroll
    for (int qg = 0; qg < 2; ++qg) { float lt = l[qg]; lt += __shfl_xor(lt, 16); lt += __shfl_xor(lt, 32); const float inv = 1.0f / lt;
        bf16* rp = Op + (size_t)(row0 + 16 * qg + j) * ldo + 4 * g;
#pragma unroll
        for (int ds = 0; ds < 8; ++ds) { const f32x4 v = o[qg][ds] * inv; v2u w; w.x = pk2(v.x, v.y); w.y = pk2(v.z, v.w); *(v2u*)(rp + 16 * ds) = w; } }
}

__device__ __forceinline__ void moba_unit(LAS unsigned char* L, const bf16* proj, const float* kmean, const float* rel_bias, bf16* Ob, int b, int h, int qb, int tid_) {
    int tid = tid_; asm volatile("" : "+v"(tid));
    const int lane = tid & 63, wave = __builtin_amdgcn_readfirstlane(tid >> 6), j = lane & 15, g = lane >> 4;
    const bf16* Qp = proj + (size_t)(b * SEQ + 256 * qb) * IN_W + COL_QM + h * HD;
    const bf16* Kp = proj + (size_t)(b * SEQ) * IN_W + COL_KM + h * HD;
    const bf16* Vp = proj + (size_t)(b * SEQ) * IN_W + COL_VM + h * HD;
    bf16* Op = Ob + (size_t)(b * SEQ + 256 * qb) * DM + h * HD;
    const int ntiles = 4 + 4 * qb;
    __syncthreads();
    { const int idx = tid * 4, n = idx >> 7; f32x4 v = (f32x4){0.f, 0.f, 0.f, 0.f};
      if (n < qb) v = *(const f32x4*)(kmean + (size_t)((b * 16 + n) * 16 + h) * 128 + (idx & 127)) * (1.0f / 256.0f);
      *(LAS f32x4*)(L + KM_OFF + idx * 4) = v; }
    if (tid < 128) *(LAS float*)(L + LUT_OFF + tid * 4) = rel_bias[t5_bucket(tid) * 32 + h] * LOG2E;
    if (tid == 128) *(LAS float*)(L + LUT_OFF + 128 * 4) = -INFINITY;
    v4u kr[2], vr[2];
    kv_load(Kp + (size_t)(256 * qb) * IN_W, Vp + (size_t)(256 * qb) * IN_W, IN_W, tid, kr, vr);
    bf16x8 qf[2][4];
    q_load(Qp, IN_W, 32 * wave, j, g, qf);
    kv_store(L, tid, kr, vr);
    kv_load(Kp + (size_t)(256 * qb + 64) * IN_W, Vp + (size_t)(256 * qb + 64) * IN_W, IN_W, tid, kr, vr);
    __syncthreads();
    unsigned sel[2];
    {
        float v1[2] = {-INFINITY, -INFINITY}, v2[2] = {-INFINITY, -INFINITY}, v3[2] = {-INFINITY, -INFINITY}; int i1[2] = {-1, -1}, i2[2] = {-1, -1}, i3[2] = {-1, -1};
#pragma unroll 1
        for (int n = 0; n < qb; ++n) {
            float a[2] = {0.f, 0.f};
#pragma unroll
            for (int dd = 0; dd < 4; ++dd) { const LAS f32x4* kp = (const LAS f32x4*)(L + KM_OFF + (n * 128 + 32 * dd + 8 * g) * 4); const f32x4 ka = kp[0], kb = kp[1];
#pragma unroll
                for (int qg = 0; qg < 2; ++qg) { a[qg] += bf2f(qf[qg][dd][0]) * ka.x; a[qg] += bf2f(qf[qg][dd][1]) * ka.y; a[qg] += bf2f(qf[qg][dd][2]) * ka.z; a[qg] += bf2f(qf[qg][dd][3]) * ka.w;
                    a[qg] += bf2f(qf[qg][dd][4]) * kb.x; a[qg] += bf2f(qf[qg][dd][5]) * kb.y; a[qg] += bf2f(qf[qg][dd][6]) * kb.z; a[qg] += bf2f(qf[qg][dd][7]) * kb.w; } }
#pragma unroll
            for (int qg = 0; qg < 2; ++qg) { float v = a[qg]; v += __shfl_xor(v, 16); v += __shfl_xor(v, 32);
                const bool c1 = v > v1[qg], c2 = v > v2[qg], c3 = v > v3[qg];
                v3[qg] = c2 ? v2[qg] : (c3 ? v : v3[qg]); i3[qg] = c2 ? i2[qg] : (c3 ? n : i3[qg]);
                v2[qg] = c1 ? v1[qg] : (c2 ? v : v2[qg]); i2[qg] = c1 ? i1[qg] : (c2 ? n : i2[qg]);
                v1[qg] = c1 ? v : v1[qg];                 i1[qg] = c1 ? n : i1[qg]; }
        }
#pragma unroll
        for (int qg = 0; qg < 2; ++qg) sel[qg] = (i1[qg] >= 0 ? (1u << i1[qg]) : 0u) | (i2[qg] >= 0 ? (1u << i2[qg]) : 0u) | (i3[qg] >= 0 ? (1u << i3[qg]) : 0u);
    }
    float m[2] = {-INFINITY, -INFINITY}, l[2] = {0.f, 0.f}; f32x4 o[2][8];
#pragma unroll
    for (int qg = 0; qg < 2; ++qg)
#pragma unroll
        for (int ds = 0; ds < 8; ++ds) o[qg][ds] = (f32x4){0.f, 0.f, 0.f, 0.f};
    const LAS float* lut = (const LAS float*)(L + LUT_OFF);
    const float lutfar = lut[127];
#pragma unroll 1
    for (int it = 0; it < ntiles; ++it) {
        LAS unsigned char* Lb = L + (it & 1) * TILE_BYTES;
        if (it + 1 < ntiles) kv_store(L + ((it + 1) & 1) * TILE_BYTES, tid, kr, vr);
        const bool own = it < 4; const int n = own ? qb : ((it - 4) >> 2), kt = own ? it : ((it - 4) & 3);
        if (it + 2 < ntiles) { const int it2 = it + 2; const bool own2 = it2 < 4; const int n2 = own2 ? qb : ((it2 - 4) >> 2), kt2 = own2 ? it2 : ((it2 - 4) & 3);
            const size_t kro = (size_t)(256 * n2 + 64 * kt2) * IN_W; kv_load(Kp + kro, Vp + kro, IN_W, tid, kr, vr); }
        bool active;
        if (own) active = (64 * kt <= 32 * wave + 31);
        else active = __any((int)(((sel[0] | sel[1]) >> n) & 1u)) != 0;
        if (active) {
            f32x4 t[2][4];
            qk_tile(Lb, qf, t, j, g);
            const int dbase = 256 * (qb - n) - 64 * kt + 32 * wave;
            if ((dbase - 63) < 127) {
#pragma unroll
                for (int qg = 0; qg < 2; ++qg) { const bool selq = own || (((sel[qg] >> n) & 1u) != 0u);
#pragma unroll
                    for (int ks = 0; ks < 4; ++ks)
#pragma unroll
                        for (int r = 0; r < 4; ++r) { const int d = dbase + (16 * qg + j) - (16 * ks + 4 * g + r);
                            const int dc = (selq && d >= 0) ? (d > 127 ? 127 : d) : 128;
                            t[qg][ks][r] = fmaf(t[qg][ks][r], QK_C, lut[dc]); } }
            } else {
#pragma unroll
                for (int qg = 0; qg < 2; ++qg) { const float bq = (own || (((sel[qg] >> n) & 1u) != 0u)) ? lutfar : -INFINITY;
#pragma unroll
                    for (int ks = 0; ks < 4; ++ks)
#pragma unroll
                        for (int r = 0; r < 4; ++r) t[qg][ks][r] = fmaf(t[qg][ks][r], QK_C, bq); }
            }
            bf16x8 pf[2][2];
            sm_update(t, m, l, o, pf);
            pv_tile(Lb, pf, o, lane);
        }
        __syncthreads();
    }
    o_store(Op, DM, 32 * wave, l, o, j, g);
}

__device__ __forceinline__ void swa_unit(LAS unsigned char* L, const bf16* proj, const float* rel_bias, const float* sinks, bf16* Ob, int b, int kvh, int i, int p, int tid_) {
    int tid = tid_; asm volatile("" : "+v"(tid));
    const int lane = tid & 63, wave = __builtin_amdgcn_readfirstlane(tid >> 6);
    const int j = lane & 15, g = lane >> 4, w4 = wave & 3, hq = 4 * kvh + 2 * p + (wave >> 2);
    const bf16* Qp = proj + (size_t)(b * SEQ + 128 * i) * IN_W + COL_QS + hq * HD;
    const bf16* Kp = proj + (size_t)(b * SEQ) * IN_W + COL_KS + kvh * HD;
    const bf16* Vp = proj + (size_t)(b * SEQ) * IN_W + COL_VS + kvh * HD;
    bf16* Op = Ob + (size_t)(b * SEQ + 128 * i) * DM + MOBA_W + hq * HD;
    const int kt0 = (i == 0) ? 2 : 0;
    __syncthreads();
    if (tid < 256) { const int hh = 4 * kvh + 2 * p + (tid >> 7), d = tid & 127; *(LAS float*)(L + LUT_OFF + ((tid >> 7) * LUT_STRIDE + d) * 4) = rel_bias[t5_bucket(d) * 32 + 16 + hh] * LOG2E; }
    if (tid >= 256 && tid < 258) *(LAS float*)(L + LUT_OFF + ((tid - 256) * LUT_STRIDE + 128) * 4) = -INFINITY;
    v4u kr[2], vr[2];
    { const long kro = (long)(128 * (i - 1) + 64 * kt0) * IN_W; kv_load(Kp + kro, Vp + kro, IN_W, tid, kr, vr); }
    bf16x8 qf[2][4];
    q_load(Qp, IN_W, 32 * w4, j, g, qf);
    kv_store(L + (kt0 & 1) * TILE_BYTES, tid, kr, vr);
    { const long kro = (long)(128 * (i - 1) + 64 * (kt0 + 1)) * IN_W; kv_load(Kp + kro, Vp + kro, IN_W, tid, kr, vr); }
    __syncthreads();
    const float sk = sinks[hq] * LOG2E;
    float m[2] = {sk, sk}, l[2] = {g == 0 ? 1.f : 0.f, g == 0 ? 1.f : 0.f}; f32x4 o[2][8];
#pragma unroll
    for (int qg = 0; qg < 2; ++qg)
#pragma unroll
        for (int ds = 0; ds < 8; ++ds) o[qg][ds] = (f32x4){0.f, 0.f, 0.f, 0.f};
    const LAS float* lut = (const LAS float*)(L + LUT_OFF) + LUT_STRIDE * (wave >> 2);
#pragma unroll 1
    for (int kt = kt0; kt < 4; ++kt) {
        LAS unsigned char* Lb = L + (kt & 1) * TILE_BYTES;
        if (kt + 1 < 4) kv_store(L + ((kt + 1) & 1) * TILE_BYTES, tid, kr, vr);
        if (kt + 2 < 4) { const long kro = (long)(128 * (i - 1) + 64 * (kt + 2)) * IN_W; kv_load(Kp + kro, Vp + kro, IN_W, tid, kr, vr); }
        const int dbase = 128 + 32 * w4 - 64 * kt;
        const bool active = (dbase + 31 >= 0) && (dbase - 63 <= 127);
        if (active) {
            f32x4 t[2][4];
            qk_tile(Lb, qf, t, j, g);
#pragma unroll
            for (int qg = 0; qg < 2; ++qg)
#pragma unroll
                for (int ks = 0; ks < 4; ++ks)
#pragma unroll
                    for (int r = 0; r < 4; ++r) { const int d = dbase + (16 * qg + j) - (16 * ks + 4 * g + r);
                        const int dc = ((unsigned)d < 128u) ? d : 128;
                        t[qg][ks][r] = fmaf(t[qg][ks][r], QK_C, lut[dc]); }
            bf16x8 pf[2][2];
            sm_update(t, m, l, o, pf);
            pv_tile(Lb, pf, o, lane);
        }
        __syncthreads();
    }
    o_store(Op, DM, 32 * w4, l, o, j, g);
}

__device__ __forceinline__ void cross_unit(LAS unsigned char* L, const bf16* qc, const bf16* kvc, bf16* oc, int b, int hc, int qt, int tid_) {
    int tid = tid_; asm volatile("" : "+v"(tid));
    const int lane = tid & 63, wave = __builtin_amdgcn_readfirstlane(tid >> 6), j = lane & 15, g = lane >> 4;
    const bf16* Qp = qc + (size_t)(b * SEQ + 256 * qt) * CROSS_W + hc * HD;
    const bf16* Kp = kvc + (size_t)(b * NMEM) * 1024 + hc * HD;
    const bf16* Vp = Kp + 512;
    bf16* Op = oc + (size_t)(b * SEQ + 256 * qt) * CROSS_W + hc * HD;
    __syncthreads();
    v4u kr[2], vr[2];
    kv_load(Kp, Vp, 1024, tid, kr, vr);
    bf16x8 qf[2][4];
    q_load(Qp, CROSS_W, 32 * wave, j, g, qf);
    kv_store(L, tid, kr, vr);
    kv_load(Kp + (size_t)64 * 1024, Vp + (size_t)64 * 1024, 1024, tid, kr, vr);
    __syncthreads();
    float m[2] = {-INFINITY, -INFINITY}, l[2] = {0.f, 0.f}; f32x4 o[2][8];
#pragma unroll
    for (int qg = 0; qg < 2; ++qg)
#pragma unroll
        for (int ds = 0; ds < 8; ++ds) o[qg][ds] = (f32x4){0.f, 0.f, 0.f, 0.f};
#pragma unroll 1
    for (int kt = 0; kt < 4; ++kt) {
        LAS unsigned char* Lb = L + (kt & 1) * TILE_BYTES;
        if (kt + 1 < 4) kv_store(L + ((kt + 1) & 1) * TILE_BYTES, tid, kr, vr);
        if (kt + 2 < 4) { const size_t kro = (size_t)(64 * (kt + 2)) * 1024; kv_load(Kp + kro, Vp + kro, 1024, tid, kr, vr); }
        f32x4 t[2][4];
        qk_tile(Lb, qf, t, j, g);
#pragma unroll
        for (int qg = 0; qg < 2; ++qg)
#pragma unroll
            for (int ks = 0; ks < 4; ++ks) t[qg][ks] = t[qg][ks] * QK_C;
        bf16x8 pf[2][2];
        sm_update(t, m, l, o, pf);
        pv_tile(Lb, pf, o, lane);
        __syncthreads();
    }
    o_store(Op, CROSS_W, 32 * wave, l, o, j, g);
}

__device__ __forceinline__ void kmean_item(LAS unsigned char* L, const bf16* proj, float* kmean, int b, int n, int h, int tid, int wave, int lane) {
    const bf16* Kp = proj + (size_t)(b * SEQ + 256 * n) * IN_W + COL_KM + h * HD;
    float acc[8];
#pragma unroll
    for (int e = 0; e < 8; ++e) acc[e] = 0.f;
#pragma unroll
    for (int i = 0; i < 8; ++i) { const int row = 32 * wave + 4 * i + (lane >> 4); const v4u v = *(const v4u*)(Kp + (size_t)row * IN_W + (lane & 15) * 8);
#pragma unroll
        for (int e = 0; e < 4; ++e) { acc[2 * e] += bf_lo(v[e]); acc[2 * e + 1] += bf_hi(v[e]); } }
#pragma unroll
    for (int e = 0; e < 8; ++e) { acc[e] += __shfl_xor(acc[e], 16); acc[e] += __shfl_xor(acc[e], 32); }
    __syncthreads();
    if (lane < 16) {
#pragma unroll
        for (int e = 0; e < 8; ++e) *(LAS float*)(L + RED_OFF + (wave * 128 + lane * 8 + e) * 4) = acc[e]; }
    __syncthreads();
    if (tid < 128) { float s = 0.f;
#pragma unroll
        for (int w = 0; w < 8; ++w) s += *(LAS float*)(L + RED_OFF + (w * 128 + tid) * 4);
        kmean[(size_t)((b * 16 + n) * 16 + h) * 128 + tid] = s * (1.f / 256.f); }
}
}

enum Phase { PH_PRO = 0, PH_GU1, PH_DN1, PH_NORM2, PH_WIN, PH_KMEAN, PH_ATTN, PH_ONORM, PH_WOUT, PH_NORM3, PH_CQ, PH_CATTN, PH_CO, PH_NORM4, PH_GU2, PH_DN2, PH_FINAL, NPH };
enum In { I_X = 0, I_MEM, I_RELB, I_GFINAL, I_GFFN1, I_W1G, I_W1U, I_W1D, I_GMIX, I_WIN, I_BIN, I_SINKS, I_GOM, I_GOS, I_WOUT, I_GCROSS, I_GMEM, I_WCQ, I_WCK, I_WCV, I_WCO, I_GFFN2, I_W2G, I_W2U, I_W2D, N_IN };
struct Args { const float* in[N_IN]; float* out; unsigned char* ws; int ph_lo, ph_hi; };
static_assert(sizeof(Args) == N_IN * 8 + 8 + 8 + 8, "Args has no padding bytes");

constexpr int W2D_TAIL_ITEMS = 12000;
constexpr float W2GU_SCALE = 64.f, W2D_SCALE = 128.f, H2_SCALE = 8.f, WOUT_SCALE = 64.f, WCQ_SCALE = 64.f;
#define PG8_ALIGN true
#define PG8_SP2 true

__global__ void __launch_bounds__(NWAVES * 64, 2) hymba_fwd(Args args) {
    extern __shared__ __attribute__((aligned(16))) unsigned char lds[];
    LAS unsigned char* L = (LAS unsigned char*)lds;
    volatile LAS unsigned* MISC = (volatile LAS unsigned*)(L + MISC_OFF);
    const int tid = threadIdx.x, lane = tid & 63, wave = __builtin_amdgcn_readfirstlane(tid >> 6);
    const int G = gridDim.x, bid = blockIdx.x;
    unsigned char* ws = args.ws;
    gu32* ctl = (gu32*)(ws + WS_CTL);
    float* xs = args.out;
    float* kmean = (float*)(ws + WS_KMEAN);
    bf16* kvc = (bf16*)(ws + WS_KVC); bf16* memn = (bf16*)(ws + WS_MEMN); bf16* qc = (bf16*)(ws + WS_QC); bf16* oc = (bf16*)(ws + WS_OC);
    bf16* Wcq = (bf16*)(ws + WS_WCQ); bf16* Wckv = (bf16*)(ws + WS_WCKV); bf16* Wco = (bf16*)(ws + WS_WCO); bf16* Wout = (bf16*)(ws + WS_WOUT); bf16* Win = (bf16*)(ws + WS_WIN);
    bf16* Wgu1 = (bf16*)(ws + WS_WGU1); bf16* Wd1 = (bf16*)(ws + WS_WD1); bf16* Wgu2 = (bf16*)(ws + WS_WGU2); bf16* Wd2 = (bf16*)(ws + WS_WD2);
    bf16* NB_ = (bf16*)(ws + WS_N); bf16* HB = (bf16*)(ws + WS_H); bf16* PROJ = (bf16*)(ws + WS_H);
    for (int u = tid; u < (LDS_BYTES - LDSCTL_OFF) / 4; u += NWAVES * 64) ((LAS unsigned*)(L + LDSCTL_OFF))[u] = 0u;
    __syncthreads();
    const int lo = args.ph_lo, hi = args.ph_hi;
    const bool use_bar = (hi - lo) > 1;
    XcdBarrier bar; bar.bar = (unsigned*)(ctl + CW_BAR); bar.x = 0; bar.st = nullptr;
    if (use_bar) bar = xcd_barrier_post((unsigned*)(ctl + CW_BAR), MISC + 8);
#ifndef PH_MASK
#define PH_MASK 0xFFFFFFFFu
#endif
#define IN(k) ((((PH_MASK) >> (k)) & 1u) && lo <= (k) && (k) < hi)
#ifndef DUP_MASK
#define DUP_MASK 0u
#endif
#define REPS(k) ((((DUP_MASK) >> (k)) & 1u) ? 2 : 1)
#define SEAM(k) do { if (IN(k) && IN((k) + 1)) xcd_barrier(bar); } while (0)
    const int gw = bid * NWAVES + wave, NGW = G * NWAVES;

    if (IN(PH_PRO)) _Pragma("unroll") for (int rep_ = 0; rep_ < REPS(PH_PRO); ++rep_) { if (rep_) xcd_barrier(bar);
        LAS float* scr = (LAS float*)(L + RING_OFF + wave * 16384);
        constexpr int I_FF = (DM / 64) * (FF / 32);
        constexpr int I_IN = (DM / 64) * (IN_W / 32), I_OUT = (DM / 64) * (DM / 32), I_C = (DM / 64) * (CROSS_W / 32), I_CO = (CROSS_W / 64) * (DM / 32);
        constexpr int NITEMS = 6 * I_FF - W2D_TAIL_ITEMS + I_IN + I_OUT + 3 * I_C + I_CO;
        for (int it = gw; it < NITEMS; it += NGW) {
            int r = it;
            if (r < I_FF) { cvt_item(args.in[I_W1G], DM, FF, Wgu1, 128, 256, 0, scr, r, lane); continue; } r -= I_FF;
            if (r < I_FF) { cvt_item(args.in[I_W1U], DM, FF, Wgu1, 128, 256, 128, scr, r, lane); continue; } r -= I_FF;
            if (r < I_FF) { cvt_item(args.in[I_W1D], FF, DM, Wd1, DM, 0, 0, scr, r, lane); continue; } r -= I_FF;
            if (r < I_IN) { cvt_item(args.in[I_WIN], DM, IN_W, Win, IN_W, 0, 0, scr, r, lane); continue; } r -= I_IN;
            if (r < I_OUT) { cvt_item_f8(args.in[I_WOUT], DM, DM, (unsigned char*)Wout, DM, 0, 0, WOUT_SCALE, scr, r, lane); continue; } r -= I_OUT;
            if (r < I_C) { cvt_item_f8(args.in[I_WCQ], DM, CROSS_W, (unsigned char*)Wcq, CROSS_W, 0, 0, WCQ_SCALE, scr, r, lane); continue; } r -= I_C;
            if (r < I_C) { cvt_item(args.in[I_WCK], DM, CROSS_W, Wckv, CROSS_W, 0, 0, scr, r, lane); continue; } r -= I_C;
            if (r < I_C) { cvt_item(args.in[I_WCV], DM, CROSS_W, Wckv, CROSS_W, 0, 512, scr, r, lane); continue; } r -= I_C;
            if (r < I_CO) { cvt_item(args.in[I_WCO], CROSS_W, DM, Wco, DM, 0, 0, scr, r, lane); continue; } r -= I_CO;
            if (r < I_FF) { cvt_item_f8(args.in[I_W2G], DM, FF, (unsigned char*)Wgu2, 128, 256, 0, W2GU_SCALE, scr, r, lane); continue; } r -= I_FF;
            if (r < I_FF) { cvt_item_f8(args.in[I_W2U], DM, FF, (unsigned char*)Wgu2, 128, 256, 128, W2GU_SCALE, scr, r, lane); continue; } r -= I_FF;
            cvt_item_f8(args.in[I_W2D], FF, DM, (unsigned char*)Wd2, DM, 0, 0, W2D_SCALE, scr, r + W2D_TAIL_ITEMS, lane);
        }
        for (int m = gw; m < M; m += NGW) rms_row_bf16(args.in[I_X] + (size_t)m * DM, args.in[I_GFFN1], NB_ + (size_t)m * DM, lane);
        for (int m = gw; m < NB * NMEM; m += NGW) rms_row_bf16(args.in[I_MEM] + (size_t)m * DM, args.in[I_GMEM], memn + (size_t)m * DM, lane);
        __syncthreads();
    }
    SEAM(PH_PRO);

    if (IN(PH_GU1)) _Pragma("unroll") for (int rep_ = 0; rep_ < REPS(PH_GU1); ++rep_) { if (rep_) xcd_barrier(bar);
        { pg8::Gemm g{NB_, Wgu1, M, 2 * FF, DM}; pg8::StaticOrder S; S.init(M, 2 * FF, G, bid);
          pg8::EpiSwiGLU E{HB, FF};
          pg8::gemm_phase<pg8::EpiSwiGLU, pg8::StaticOrder, PG8_ALIGN, PG8_SP2>(L + RING_OFF, g, S, E); }
        { const int rem = ((M / 256) * (2 * FF / 256)) % G; const int c2 = (bid >= rem) ? bid - rem : bid + (G - rem);
          pg8::Gemm g{memn, Wckv, NB * NMEM, 1024, DM}; pg8::StaticOrder S; S.init(NB * NMEM, 1024, G, c2);
          pg8::EpiBf16B E{kvc, 1024, nullptr, 1.0f};
          pg8::gemm_phase<pg8::EpiBf16B, pg8::StaticOrder, PG8_ALIGN, PG8_SP2>(L + RING_OFF, g, S, E);
          const int nidle = (rem == 0) ? 0 : (G - rem - 16);
          if (nidle > 0 && c2 >= 16 && c2 < G - rem) { __syncthreads();
              LAS float* scr = (LAS float*)(L + RING_OFF + wave * 16384); constexpr int I_FF = (DM / 64) * (FF / 32);
              for (int it = (c2 - 16) * NWAVES + wave; it < W2D_TAIL_ITEMS; it += nidle * NWAVES) cvt_item_f8(args.in[I_W2D], FF, DM, (unsigned char*)Wd2, DM, 0, 0, W2D_SCALE, scr, it, lane);
              __syncthreads(); }
          else if (nidle <= 0) { __syncthreads();
              LAS float* scr = (LAS float*)(L + RING_OFF + wave * 16384); constexpr int I_FF = (DM / 64) * (FF / 32);
              for (int it = gw; it < W2D_TAIL_ITEMS; it += NGW) cvt_item_f8(args.in[I_W2D], FF, DM, (unsigned char*)Wd2, DM, 0, 0, W2D_SCALE, scr, it, lane);
              __syncthreads(); } }
    }
    SEAM(PH_GU1);

    if (IN(PH_DN1)) _Pragma("unroll") for (int rep_ = 0; rep_ < REPS(PH_DN1); ++rep_) { if (rep_) xcd_barrier(bar);
        pg8::Gemm g{HB, Wd1, M, DM, FF}; pg8::StaticOrder S; S.init(M, DM, G, bid);
        pg8::EpiResF32 E{args.in[I_X], xs, DM, 0.5f};
        pg8::gemm_phase<pg8::EpiResF32, pg8::StaticOrder, PG8_ALIGN, PG8_SP2>(L + RING_OFF, g, S, E);
    }
    SEAM(PH_DN1);

    if (IN(PH_NORM2)) _Pragma("unroll") for (int rep_ = 0; rep_ < REPS(PH_NORM2); ++rep_) { if (rep_) xcd_barrier(bar); for (int m = gw; m < M; m += NGW) rms_row_bf16(xs + (size_t)m * DM, args.in[I_GMIX], NB_ + (size_t)m * DM, lane); }
    SEAM(PH_NORM2);

    if (IN(PH_WIN)) _Pragma("unroll") for (int rep_ = 0; rep_ < REPS(PH_WIN); ++rep_) { if (rep_) xcd_barrier(bar);
        pg8::Gemm g{NB_, Win, M, IN_W, DM}; pg8::StaticOrder S; S.init(M, IN_W, G, bid);
        pg8::EpiProj E{PROJ, IN_W, args.in[I_BIN], kmean, COL_KM};
        pg8::gemm_phase<pg8::EpiProj, pg8::StaticOrder, PG8_ALIGN, PG8_SP2>(L + RING_OFF, g, S, E);
    }
    SEAM(PH_WIN);


    if (IN(PH_ATTN)) _Pragma("unroll") for (int rep_ = 0; rep_ < REPS(PH_ATTN); ++rep_) { if (rep_) xcd_barrier(bar);
        for (int c = bid; c < 256; c += G) {
#ifndef NO_MOBA
            { const int b = c >> 6, h = (c >> 2) & 15, r = c & 3;
#pragma unroll 1
              for (int q = 0; q < 4; ++q) { const int qb = (q == 0) ? 15 - r : (q == 1) ? 11 - r : (q == 2) ? 4 + r : r;
                  att::moba_unit(L, PROJ, kmean, args.in[I_RELB], NB_, b, h, qb, tid); } }
#endif
#ifndef NO_SWA
            { const int b = c >> 6, kvh = (c >> 4) & 3, ib = c & 15;
#pragma unroll 1
              for (int q = 0; q < 4; ++q) att::swa_unit(L, PROJ, args.in[I_RELB], args.in[I_SINKS], NB_, b, kvh, 2 * ib + (q >> 1), q & 1, tid); }
#endif
        }
        __syncthreads();
    }
    SEAM(PH_ATTN);

    if (IN(PH_ONORM)) _Pragma("unroll") for (int rep_ = 0; rep_ < REPS(PH_ONORM); ++rep_) { if (rep_) xcd_barrier(bar); for (int m = gw; m < M; m += NGW) onorm_row_f8(NB_ + (size_t)m * DM, (unsigned char*)HB + (size_t)m * DM, args.in[I_GOM], args.in[I_GOS], lane); }
    SEAM(PH_ONORM);

    if (IN(PH_WOUT)) _Pragma("unroll") for (int rep_ = 0; rep_ < REPS(PH_WOUT); ++rep_) { if (rep_) xcd_barrier(bar);
        pg8::Gemm g{HB, Wout, M, DM, DM}; pg8::StaticOrder S; S.init(M, DM, G, bid);
        pg8::EpiResF32 E{xs, xs, DM, 1.0f / WOUT_SCALE};
        pg8::gemm_phase<pg8::EpiResF32, pg8::StaticOrder, PG8_ALIGN, PG8_SP2, true>(L + RING_OFF, g, S, E);
    }
    SEAM(PH_WOUT);

    if (IN(PH_NORM3)) _Pragma("unroll") for (int rep_ = 0; rep_ < REPS(PH_NORM3); ++rep_) { if (rep_) xcd_barrier(bar); for (int m = gw; m < M; m += NGW) rms_row_f8(xs + (size_t)m * DM, args.in[I_GCROSS], (unsigned char*)NB_ + (size_t)m * DM, lane); }
    SEAM(PH_NORM3);

    if (IN(PH_CQ)) _Pragma("unroll") for (int rep_ = 0; rep_ < REPS(PH_CQ); ++rep_) { if (rep_) xcd_barrier(bar);
        pg8::Gemm g{NB_, Wcq, M, CROSS_W, DM}; pg8::StaticOrder S; S.init(M, CROSS_W, G, bid);
        pg8::EpiBf16B E{qc, CROSS_W, nullptr, 1.0f / WCQ_SCALE};
        pg8::gemm_phase<pg8::EpiBf16B, pg8::StaticOrder, PG8_ALIGN, PG8_SP2, true>(L + RING_OFF, g, S, E);
    }
    SEAM(PH_CQ);

    if (IN(PH_CATTN)) _Pragma("unroll") for (int rep_ = 0; rep_ < REPS(PH_CATTN); ++rep_) { if (rep_) xcd_barrier(bar);
        for (int c = bid; c < 256; c += G) att::cross_unit(L, qc, kvc, oc, c >> 6, (c >> 4) & 3, c & 15, tid);
        __syncthreads();
    }
    SEAM(PH_CATTN);

    if (IN(PH_CO)) _Pragma("unroll") for (int rep_ = 0; rep_ < REPS(PH_CO); ++rep_) { if (rep_) xcd_barrier(bar);
        pg8::Gemm g{oc, Wco, M, DM, CROSS_W}; pg8::StaticOrder S; S.init(M, DM, G, bid);
        pg8::EpiResF32 E{xs, xs, DM, 1.0f};
        pg8::gemm_phase<pg8::EpiResF32, pg8::StaticOrder, PG8_ALIGN, PG8_SP2>(L + RING_OFF, g, S, E);
    }
    SEAM(PH_CO);

    if (IN(PH_NORM4)) _Pragma("unroll") for (int rep_ = 0; rep_ < REPS(PH_NORM4); ++rep_) { if (rep_) xcd_barrier(bar); for (int m = gw; m < M; m += NGW) rms_row_f8(xs + (size_t)m * DM, args.in[I_GFFN2], (unsigned char*)NB_ + (size_t)m * DM, lane); }
    SEAM(PH_NORM4);

    if (IN(PH_GU2)) _Pragma("unroll") for (int rep_ = 0; rep_ < REPS(PH_GU2); ++rep_) { if (rep_) xcd_barrier(bar);
        pg8::Gemm g{NB_, Wgu2, M, 2 * FF, DM}; pg8::StaticOrder S; S.init(M, 2 * FF, G, bid);
        pg8::EpiSwiGLUF8 E{(unsigned char*)HB, FF, 1.0f / W2GU_SCALE, H2_SCALE};
        pg8::gemm_phase<pg8::EpiSwiGLUF8, pg8::StaticOrder, PG8_ALIGN, PG8_SP2, true>(L + RING_OFF, g, S, E);
    }
    SEAM(PH_GU2);

    if (IN(PH_DN2)) _Pragma("unroll") for (int rep_ = 0; rep_ < REPS(PH_DN2); ++rep_) { if (rep_) xcd_barrier(bar);
        pg8::Gemm g{HB, Wd2, M, DM, FF}; pg8::StaticOrder S; S.init(M, DM, G, bid);
        pg8::EpiResF32 E{xs, xs, DM, 0.5f / (W2D_SCALE * H2_SCALE)};
        pg8::gemm_phase<pg8::EpiResF32, pg8::StaticOrder, PG8_ALIGN, PG8_SP2, true>(L + RING_OFF, g, S, E);
    }
    SEAM(PH_DN2);

    if (IN(PH_FINAL)) _Pragma("unroll") for (int rep_ = 0; rep_ < REPS(PH_FINAL); ++rep_) { if (rep_) xcd_barrier(bar); for (int m = gw; m < M; m += NGW) rms_row_f32(xs + (size_t)m * DM, args.in[I_GFINAL], lane); }
#undef IN
#undef SEAM
}

#ifndef MK_ONE_LAUNCH
#define MK_ONE_LAUNCH 1
#endif
extern "C" void kernel_launch(void* const* d_in, const int* in_sizes, int n_in, void* d_out, int out_size, void* d_ws, size_t ws_size, hipStream_t stream) {
    static int grid = 0;
    if (grid == 0) {
        if (n_in != N_IN || in_sizes[0] != M * DM || out_size != M * DM || ws_size < WS_END) { fprintf(stderr, "kernel_launch: unexpected shapes / workspace (n_in %d, in0 %d, out %d, ws %zu); nothing launched\n", n_in, n_in > 0 ? in_sizes[0] : -1, out_size, ws_size); grid = -1; return; }
        int dev = 0, cus = 0, per_cu = 0;
        if (hipGetDevice(&dev) != hipSuccess || hipDeviceGetAttribute(&cus, hipDeviceAttributeMultiprocessorCount, dev) != hipSuccess) { fprintf(stderr, "kernel_launch: hipGetDevice / hipDeviceGetAttribute failed\n"); grid = -1; return; }
        if (hipFuncSetAttribute((const void*)hymba_fwd, hipFuncAttributeMaxDynamicSharedMemorySize, LDS_BYTES) != hipSuccess) { fprintf(stderr, "kernel_launch: hipFuncSetAttribute failed\n"); grid = -1; return; }
        if (hipOccupancyMaxActiveBlocksPerMultiprocessor(&per_cu, (const void*)hymba_fwd, NWAVES * 64, LDS_BYTES) != hipSuccess || per_cu < 1) { fprintf(stderr, "kernel_launch: occupancy query reports %d workgroups per CU\n", per_cu); }
        (void)hipGetLastError();
        grid = cus;
    }
    if (grid < 0) return;
    (void)hipMemsetAsync((char*)d_ws + WS_CTL, 0, CTL_ZERO_BYTES, stream);
    Args a{};
    for (int i = 0; i < N_IN; ++i) a.in[i] = (const float*)d_in[i];
    a.out = (float*)d_out; a.ws = (unsigned char*)d_ws;
#if MK_ONE_LAUNCH
    a.ph_lo = 0; a.ph_hi = NPH;
    hipLaunchKernelGGL(hymba_fwd, dim3(grid), dim3(NWAVES * 64), LDS_BYTES, stream, a);
#else
    for (int ph = 0; ph < NPH; ++ph) { a.ph_lo = ph; a.ph_hi = ph + 1; hipLaunchKernelGGL(hymba_fwd, dim3(grid), dim3(NWAVES * 64), LDS_BYTES, stream, a); }
#endif
}
```

```cpp
#include <hip/hip_runtime.h>
#include <cstdio>
#include <cstdint>
#include <cmath>
namespace pg8 {
#define PG8_LAS __attribute__((address_space(3)))
typedef unsigned short bf16_t;
typedef short bf16x8 __attribute__((ext_vector_type(8)));
typedef float f32x4 __attribute__((ext_vector_type(4)));
typedef unsigned u32x4 __attribute__((ext_vector_type(4)));
constexpr int BM = 256, BK = 64, HALF = 128, HTB = HALF * BK * 2  , STAGE_BYTES = 8 * HTB, NXCD = 8, WGM = 8;

__host__ __device__ __forceinline__ int lds_byte(int r, int c) { const int st = (r >> 4) * 2 + (c >> 5), rr = r & 15, cc = c & 31, ob = rr * 64 + cc * 2; return st * 1024 + (ob ^ (((ob >> 9) & 1) << 5)); }
__host__ __device__ __forceinline__ void stage_rc(int b, int& R, int& C) { const int st = b / 1024, sb = b % 1024, swz = sb ^ (((sb >> 9) & 1) << 5); R = (st >> 1) * 16 + swz / 64; C = (st & 1) * 32 + (swz % 64) / 2; }
__host__ __device__ __forceinline__ int perm32(int rho) { const int n = rho >> 4, i = rho & 15; return 8 * (i >> 2) + 4 * n + (i & 3); }

struct Unit { int pm, pn; };
struct Gemm { const bf16_t* A; const bf16_t* Bt; int M, N, K; };

struct StaticOrder {
    int nM, nN, nwg, G, c;
    __host__ __device__ void init(int M, int N, int G_, int c_) { nM = M / BM; nN = N / BM; nwg = nM * nN; G = G_; c = c_; }
    __host__ __device__ bool next(int i, Unit& u) const {
        const long L = (long)i * G + c; if (L >= nwg) return false;
        int wgid = (int)L; { const int q = nwg / NXCD, r = nwg % NXCD, xcd = wgid % NXCD, off = wgid / NXCD; wgid = (xcd < r ? xcd * (q + 1) : r * (q + 1) + (xcd - r) * q) + off; }
        const int nig = WGM * nN, gid = wgid / nig, fm = gid * WGM, gsz = (nM - fm) < WGM ? (nM - fm) : WGM;
        u.pm = fm + ((wgid % nig) % gsz); u.pn = (wgid % nig) / gsz; return true;
    }
    __device__ __forceinline__ void a_ready(const Unit&) const {}
    __device__ __forceinline__ void done(const Unit&) const {}
};

__device__ __forceinline__ unsigned cvt_pk_bf16(float lo, float hi) { unsigned r; asm volatile("v_cvt_pk_bf16_f32 %0, %1, %2" : "=v"(r) : "v"(lo), "v"(hi)); return r; }
typedef float f32x2 __attribute__((ext_vector_type(2)));

struct EpiBf16B {
    static constexpr bool PERM = true, AFTER_DRAIN = false;
    bf16_t* O; int ldc; const float* bias; float sc;
    __device__ __forceinline__ void operator()(const f32x4 (&acc)[2][2][4][2], const Unit& u, int wr, int wc, int fr, int fq) const {
        const int row0 = u.pm * BM + wr * 64 + fr, col0 = u.pn * BM + wc * 32 + 8 * fq;
        f32x4 bv[2][2];
#pragma unroll
        for (int bj = 0; bj < 2; ++bj)
#pragma unroll
            for (int n = 0; n < 2; ++n) bv[bj][n] = bias ? *(const f32x4*)(bias + col0 + bj * HALF + 4 * n) : (f32x4){0.f, 0.f, 0.f, 0.f};
#pragma unroll
        for (int ai = 0; ai < 2; ++ai)
#pragma unroll
            for (int m = 0; m < 4; ++m) { bf16_t* rowp = O + (size_t)(row0 + ai * HALF + m * 16) * ldc + col0;
#pragma unroll
                for (int bj = 0; bj < 2; ++bj) { const f32x4 v0 = acc[ai][bj][m][0] * sc + bv[bj][0], v1 = acc[ai][bj][m][1] * sc + bv[bj][1];
                    u32x4 w; w.x = cvt_pk_bf16(v0[0], v0[1]); w.y = cvt_pk_bf16(v0[2], v0[3]); w.z = cvt_pk_bf16(v1[0], v1[1]); w.w = cvt_pk_bf16(v1[2], v1[3]);
                    *(u32x4*)(rowp + bj * HALF) = w; } }
    }
};
__device__ __forceinline__ float silu_mul(float g, float u) { const float e = __builtin_amdgcn_exp2f(g * -1.4426950408889634f); return g * __builtin_amdgcn_rcpf(1.0f + e) * u; }
struct EpiSwiGLU {
    static constexpr bool PERM = true, AFTER_DRAIN = false;
    bf16_t* H; int ldh;
    __device__ __forceinline__ void operator()(const f32x4 (&acc)[2][2][4][2], const Unit& u, int wr, int wc, int fr, int fq) const {
        const int row0 = u.pm * BM + wr * 64 + fr, col0 = u.pn * HALF + wc * 32 + 8 * fq;
#pragma unroll
        for (int ai = 0; ai < 2; ++ai)
#pragma unroll
            for (int m = 0; m < 4; ++m) { bf16_t* rowp = H + (size_t)(row0 + ai * HALF + m * 16) * ldh + col0;
                const f32x4 g0 = acc[ai][0][m][0], g1 = acc[ai][0][m][1], u0 = acc[ai][1][m][0], u1 = acc[ai][1][m][1];
                u32x4 w; w.x = cvt_pk_bf16(silu_mul(g0[0], u0[0]), silu_mul(g0[1], u0[1])); w.y = cvt_pk_bf16(silu_mul(g0[2], u0[2]), silu_mul(g0[3], u0[3]));
                w.z = cvt_pk_bf16(silu_mul(g1[0], u1[0]), silu_mul(g1[1], u1[1])); w.w = cvt_pk_bf16(silu_mul(g1[2], u1[2]), silu_mul(g1[3], u1[3]));
                *(u32x4*)rowp = w; }
    }
};
struct EpiResF32 {
    static constexpr bool PERM = false, AFTER_DRAIN = false;
    const float* base; float* out; int ldc; float alpha;
    __device__ __forceinline__ void operator()(const f32x4 (&acc)[2][2][4][2], const Unit& u, int wr, int wc, int fr, int fq) const {
        const int row0 = u.pm * BM + wr * 64 + fr, col0 = u.pn * BM + wc * 32 + 4 * fq;
#pragma unroll
        for (int ai = 0; ai < 2; ++ai)
#pragma unroll
            for (int m = 0; m < 4; ++m) { const size_t off = (size_t)(row0 + ai * HALF + m * 16) * ldc + col0;
                f32x4 bs[2][2];
#pragma unroll
                for (int bj = 0; bj < 2; ++bj)
#pragma unroll
                    for (int n = 0; n < 2; ++n) bs[bj][n] = *(const f32x4*)(base + off + bj * HALF + n * 16);
#pragma unroll
                for (int bj = 0; bj < 2; ++bj)
#pragma unroll
                    for (int n = 0; n < 2; ++n) *(f32x4*)(out + off + bj * HALF + n * 16) = bs[bj][n] + acc[ai][bj][m][n] * alpha;
                asm volatile("" ::: "memory"); }
    }
};

__device__ __forceinline__ float clamp448(float x) { return __builtin_fminf(__builtin_fmaxf(x, -448.f), 448.f); }
__device__ __forceinline__ unsigned pk4_fp8(float a, float b, float c, float d) {
    unsigned r = 0u; r = __builtin_amdgcn_cvt_pk_fp8_f32(clamp448(a), clamp448(b), r, false); r = __builtin_amdgcn_cvt_pk_fp8_f32(clamp448(c), clamp448(d), r, true); return r; }
typedef unsigned u32x2 __attribute__((ext_vector_type(2)));
struct EpiSwiGLUF8 {
    static constexpr bool PERM = true, AFTER_DRAIN = false;
    unsigned char* H; int ldh; float inv, hs;
    __device__ __forceinline__ void operator()(const f32x4 (&acc)[2][2][4][2], const Unit& u, int wr, int wc, int fr, int fq) const {
        const int row0 = u.pm * BM + wr * 64 + fr, col0 = u.pn * HALF + wc * 32 + 8 * fq;
#pragma unroll
        for (int ai = 0; ai < 2; ++ai)
#pragma unroll
            for (int m = 0; m < 4; ++m) { unsigned char* rowp = H + (size_t)(row0 + ai * HALF + m * 16) * ldh + col0;
                const f32x4 g0 = acc[ai][0][m][0] * inv, g1 = acc[ai][0][m][1] * inv, u0 = acc[ai][1][m][0] * (inv * hs), u1 = acc[ai][1][m][1] * (inv * hs);
                u32x2 w; w.x = pk4_fp8(silu_mul(g0[0], u0[0]), silu_mul(g0[1], u0[1]), silu_mul(g0[2], u0[2]), silu_mul(g0[3], u0[3]));
                w.y = pk4_fp8(silu_mul(g1[0], u1[0]), silu_mul(g1[1], u1[1]), silu_mul(g1[2], u1[2]), silu_mul(g1[3], u1[3]));
                *(u32x2*)rowp = w; }
    }
};

struct EpiProj {
    static constexpr bool PERM = true, AFTER_DRAIN = false;
    bf16_t* O; int ldc; const float* bias; float* ksum; int kcol0;
    __device__ __forceinline__ void operator()(const f32x4 (&acc)[2][2][4][2], const Unit& u, int wr, int wc, int fr, int fq) const {
        const int row0 = u.pm * BM + wr * 64 + fr, col0 = u.pn * BM + wc * 32 + 8 * fq;
        f32x4 bv[2][2];
#pragma unroll
        for (int bj = 0; bj < 2; ++bj)
#pragma unroll
            for (int n = 0; n < 2; ++n) bv[bj][n] = *(const f32x4*)(bias + col0 + bj * HALF + 4 * n);
#pragma unroll
        for (int ai = 0; ai < 2; ++ai)
#pragma unroll
            for (int m = 0; m < 4; ++m) { bf16_t* rowp = O + (size_t)(row0 + ai * HALF + m * 16) * ldc + col0;
#pragma unroll
                for (int bj = 0; bj < 2; ++bj) { const f32x4 v0 = acc[ai][bj][m][0] + bv[bj][0], v1 = acc[ai][bj][m][1] + bv[bj][1];
                    u32x4 w; w.x = cvt_pk_bf16(v0[0], v0[1]); w.y = cvt_pk_bf16(v0[2], v0[3]); w.z = cvt_pk_bf16(v1[0], v1[1]); w.w = cvt_pk_bf16(v1[2], v1[3]);
                    *(u32x4*)(rowp + bj * HALF) = w; } }
        const int kc = u.pn * BM - kcol0;
        if (kc >= 0 && kc < 2048) {
#pragma unroll
            for (int bj = 0; bj < 2; ++bj)
#pragma unroll
                for (int n = 0; n < 2; ++n) { f32x4 s = bv[bj][n] * 8.0f;
#pragma unroll
                    for (int ai = 0; ai < 2; ++ai)
#pragma unroll
                        for (int m = 0; m < 4; ++m) s = s + acc[ai][bj][m][n];
#pragma unroll
                    for (int jj = 0; jj < 4; ++jj) { float v = s[jj]; v += __shfl_xor(v, 1); v += __shfl_xor(v, 2); v += __shfl_xor(v, 4); v += __shfl_xor(v, 8); s[jj] = v; }
                    if (fr == 0) { const int c = kc + bj * HALF + wc * 32 + 8 * fq + 4 * n;
                        float* dst = ksum + ((size_t)u.pm * 16 + (c >> 7)) * 128 + (c & 127);
#pragma unroll
                        for (int jj = 0; jj < 4; ++jj) atomicAdd(dst + jj, s[jj]); } }
        }
    }
};
typedef int v4i_t __attribute__((ext_vector_type(4))); typedef int v8i_t __attribute__((ext_vector_type(8)));
__device__ __forceinline__ v8i_t cat8(bf16x8 a, bf16x8 b) { return __builtin_shufflevector(__builtin_bit_cast(v4i_t, a), __builtin_bit_cast(v4i_t, b), 0, 1, 2, 3, 4, 5, 6, 7); }
__device__ __forceinline__ void mfma_f8(f32x4& acc, v8i_t a, v8i_t b, int one) { asm volatile("v_mfma_scale_f32_16x16x128_f8f6f4 %0, %1, %2, %0, %3, %3 op_sel_hi:[0,0,0]" : "+v"(acc) : "v"(a), "v"(b), "v"(one)); }
template <class Epi, class Sched, bool ALIGN_EPI = false, bool SP2 = false, bool F8 = false>
__device__ __forceinline__ void gemm_phase(PG8_LAS unsigned char* lds, const Gemm g, const Sched& S, const Epi& E) {
    const int tid = threadIdx.x, wid = __builtin_amdgcn_readfirstlane(tid >> 6), lane = tid & 63, wr = wid >> 2, wc = wid & 3, fr = lane & 15, fq = lane >> 4;
    const int K = g.K, KB = F8 ? K : 2 * K  , nt = KB / (BK * 2);
    unsigned voffA[2], voffB[2];
#pragma unroll
    for (int i = 0; i < 2; ++i) { int R, C; stage_rc(tid * 16 + i * 8192, R, C); const int Rb = Epi::PERM ? ((R & ~31) + perm32(R & 31)) : R;
        voffA[i] = (unsigned)(R * KB + C * 2); voffB[i] = (unsigned)(Rb * KB + C * 2); }
    const size_t kstep = (size_t)(BK * 2);
    const size_t hstep = (size_t)HALF * KB;
    const size_t tstep = 2 * hstep;
    const unsigned ldsw = (unsigned)wid * 1024u;
    const int aoff = lds_byte(wr * 64 + fr, fq * 8), boff = lds_byte(wc * 32 + fr, fq * 8);
#define PG8_SA(b, h) (((b) * 2 + (h)) * HTB)
#define PG8_SB(b, h) ((4 + (b) * 2 + (h)) * HTB)
#define PG8_STAGE(bufoff, gbase, voff) do { _Pragma("unroll") for (int _i = 0; _i < 2; ++_i) \
        __builtin_amdgcn_global_load_lds((const unsigned*)((const char*)(gbase) + (voff)[_i]), (PG8_LAS unsigned*)(lds + (bufoff) + ldsw + _i * 8192), 16, 0, 0); } while (0)
#define PG8_LDA(dst, b, h) do { _Pragma("unroll") for (int m = 0; m < 4; ++m) _Pragma("unroll") for (int k = 0; k < 2; ++k) dst[m][k] = *(const PG8_LAS bf16x8*)(lds + PG8_SA(b, h) + aoff + m * 2048 + k * 1024); } while (0)
#define PG8_LDB(dst, b, h) do { _Pragma("unroll") for (int n = 0; n < 2; ++n) _Pragma("unroll") for (int k = 0; k < 2; ++k) dst[n][k] = *(const PG8_LAS bf16x8*)(lds + PG8_SB(b, h) + boff + n * 2048 + k * 1024); } while (0)
#define PG8_MMA(ai, bj, At, Bt) do { __builtin_amdgcn_s_setprio(1); _Pragma("unroll") for (int m = 0; m < 4; ++m) _Pragma("unroll") for (int n = 0; n < 2; ++n) { \
        if constexpr (F8) mfma_f8(acc[ai][bj][m][n], cat8(Bt[n][0], Bt[n][1]), cat8(At[m][0], At[m][1]), f8_one); \
        else { _Pragma("unroll") for (int k = 0; k < 2; ++k) acc[ai][bj][m][n] = __builtin_amdgcn_mfma_f32_16x16x32_bf16(Bt[n][k], At[m][k], acc[ai][bj][m][n], 0, 0, 0); } } \
        __builtin_amdgcn_s_setprio(0); } while (0)
#define PG8_WAIT_V(n) asm volatile("s_waitcnt vmcnt(" #n ")" ::: "memory")
#define PG8_WAIT_L(n) asm volatile("s_waitcnt lgkmcnt(" #n ")" ::: "memory")
#define PG8_BAR __builtin_amdgcn_s_barrier()
#define PG8_SCHED __builtin_amdgcn_sched_barrier(0)
    Unit cur, nxt; int ui = 0;
    int f8_one = 0x7f7f7f7f; if constexpr (F8) asm volatile("" : "+v"(f8_one));
    if (!S.next(0, cur)) return;
    f32x4 acc[2][2][4][2];
#pragma unroll
    for (int a = 0; a < 2; ++a)
#pragma unroll
        for (int b = 0; b < 2; ++b)
#pragma unroll
            for (int m = 0; m < 4; ++m)
#pragma unroll
                for (int n = 0; n < 2; ++n) acc[a][b][m][n] = (f32x4){0.f, 0.f, 0.f, 0.f};
    bf16x8 At[4][2], B0[2][2], B1[2][2];
    const char* cA = (const char*)g.A + (size_t)cur.pm * tstep; const char* cB = (const char*)g.Bt + (size_t)cur.pn * tstep;
    S.a_ready(cur);
    if constexpr (SP2) {
        PG8_STAGE(PG8_SB(0, 0), cB, voffB); PG8_STAGE(PG8_SB(0, 1), cB + hstep, voffB); PG8_STAGE(PG8_SA(0, 0), cA, voffA); PG8_STAGE(PG8_SA(0, 1), cA + hstep, voffA);
        if (wr == 1) PG8_BAR;
        PG8_WAIT_V(2); PG8_BAR;
        PG8_STAGE(PG8_SB(1, 0), cB + kstep, voffB); PG8_STAGE(PG8_SA(1, 0), cA + kstep, voffA); PG8_STAGE(PG8_SB(1, 1), cB + hstep + kstep, voffB);
        PG8_WAIT_V(6); PG8_BAR;
    } else {
        PG8_STAGE(PG8_SB(0, 0), cB, voffB); PG8_STAGE(PG8_SA(0, 0), cA, voffA); PG8_STAGE(PG8_SB(0, 1), cB + hstep, voffB); PG8_STAGE(PG8_SA(0, 1), cA + hstep, voffA);
        if (wr == 1) PG8_BAR;
        PG8_WAIT_V(4); PG8_BAR;
        PG8_STAGE(PG8_SB(1, 0), cB + kstep, voffB); PG8_STAGE(PG8_SA(1, 0), cA + kstep, voffA); PG8_STAGE(PG8_SB(1, 1), cB + hstep + kstep, voffB);
        PG8_WAIT_V(6); PG8_BAR;
    }
    for (;;) {
        const bool has_next = S.next(ui + 1, nxt);
        const char* nA = has_next ? (const char*)g.A + (size_t)nxt.pm * tstep : cA; const char* nB = has_next ? (const char*)g.Bt + (size_t)nxt.pn * tstep : cB;
        for (int t = 0; t < nt; t += 2) {
            const bool last = (t == nt - 2);
            const char* a1 = cA + (size_t)(t + 1) * kstep;
            const char* a2 = last ? nA : cA + (size_t)(t + 2) * kstep; const char* b2 = last ? nB : cB + (size_t)(t + 2) * kstep;
            const char* a3 = a2 + kstep; const char* b3 = b2 + kstep;
            if (last && has_next) S.a_ready(nxt);
            if constexpr (SP2) {
            PG8_LDB(B0, 0, 0); PG8_LDB(B1, 0, 1); PG8_SCHED; PG8_LDA(At, 0, 0); PG8_STAGE(PG8_SA(1, 1), a1 + hstep, voffA);
            PG8_WAIT_V(8); PG8_WAIT_L(0); PG8_BAR; PG8_MMA(0, 0, At, B0); PG8_MMA(0, 1, At, B1); PG8_BAR; PG8_SCHED;
            PG8_LDA(At, 0, 1); PG8_STAGE(PG8_SB(0, 0), b2, voffB); PG8_STAGE(PG8_SB(0, 1), b2 + hstep, voffB); PG8_STAGE(PG8_SA(0, 0), a2, voffA);
            PG8_WAIT_V(8); PG8_WAIT_L(0); PG8_BAR; PG8_MMA(1, 0, At, B0); PG8_MMA(1, 1, At, B1); PG8_BAR; PG8_SCHED;
            PG8_LDB(B0, 1, 0); PG8_LDB(B1, 1, 1); PG8_SCHED; PG8_LDA(At, 1, 0); PG8_STAGE(PG8_SA(0, 1), a2 + hstep, voffA);
            PG8_WAIT_V(8); PG8_WAIT_L(0); PG8_BAR; PG8_MMA(0, 0, At, B0); PG8_MMA(0, 1, At, B1); PG8_BAR; PG8_SCHED;
            PG8_LDA(At, 1, 1); PG8_STAGE(PG8_SB(1, 0), b3, voffB); PG8_STAGE(PG8_SB(1, 1), b3 + hstep, voffB); PG8_STAGE(PG8_SA(1, 0), a3, voffA);
            PG8_WAIT_V(8); PG8_WAIT_L(0); PG8_BAR; PG8_MMA(1, 0, At, B0); PG8_MMA(1, 1, At, B1); PG8_BAR; PG8_SCHED;
            } else {
            PG8_LDB(B0, 0, 0); PG8_SCHED; PG8_LDA(At, 0, 0); PG8_STAGE(PG8_SA(1, 1), a1 + hstep, voffA);
            PG8_WAIT_L(8); PG8_BAR; PG8_WAIT_L(0); PG8_MMA(0, 0, At, B0); PG8_BAR; PG8_SCHED;
            PG8_LDB(B1, 0, 1); PG8_STAGE(PG8_SB(0, 0), b2, voffB);
            PG8_BAR; PG8_WAIT_L(0); PG8_MMA(0, 1, At, B1); PG8_BAR;
            PG8_LDA(At, 0, 1); PG8_STAGE(PG8_SA(0, 0), a2, voffA);
            PG8_BAR; PG8_WAIT_L(0); PG8_MMA(1, 0, At, B0); PG8_BAR; PG8_SCHED;
            PG8_STAGE(PG8_SB(0, 1), b2 + hstep, voffB);
            PG8_WAIT_V(6); PG8_BAR; PG8_MMA(1, 1, At, B1); PG8_BAR;
            PG8_LDB(B0, 1, 0); PG8_SCHED; PG8_LDA(At, 1, 0); PG8_STAGE(PG8_SA(0, 1), a2 + hstep, voffA);
            PG8_WAIT_L(8); PG8_BAR; PG8_WAIT_L(0); PG8_MMA(0, 0, At, B0); PG8_BAR; PG8_SCHED;
            PG8_LDB(B1, 1, 1); PG8_STAGE(PG8_SB(1, 0), b3, voffB);
            PG8_BAR; PG8_WAIT_L(0); PG8_MMA(0, 1, At, B1); PG8_BAR;
            PG8_LDA(At, 1, 1); PG8_STAGE(PG8_SA(1, 0), a3, voffA);
            PG8_BAR; PG8_WAIT_L(0); PG8_MMA(1, 0, At, B0); PG8_BAR; PG8_SCHED;
            PG8_STAGE(PG8_SB(1, 1), b3 + hstep, voffB);
            PG8_WAIT_V(6); PG8_BAR; PG8_MMA(1, 1, At, B1); PG8_BAR;
            }
        }
        if constexpr (ALIGN_EPI) { if (wr == 0) PG8_BAR; }
        if constexpr (!Epi::AFTER_DRAIN) { E(acc, cur, wr, wc, fr, fq); S.done(cur); }
        if (!has_next) break;
#pragma unroll
        for (int a = 0; a < 2; ++a)
#pragma unroll
            for (int b = 0; b < 2; ++b)
#pragma unroll
                for (int m = 0; m < 4; ++m)
#pragma unroll
                    for (int n = 0; n < 2; ++n) acc[a][b][m][n] = (f32x4){0.f, 0.f, 0.f, 0.f};
        cur = nxt; cA = nA; cB = nB; ++ui;
        if constexpr (ALIGN_EPI) { if (wr == 1) PG8_BAR; }
    }
    PG8_WAIT_V(0);
    if constexpr (!ALIGN_EPI) { if (wr == 0) PG8_BAR; }
    PG8_BAR;
    if constexpr (Epi::AFTER_DRAIN) { E.fused(acc, cur, wr, wc, fr, fq, lds, wid, lane); S.done(cur); }
#undef PG8_SA
#undef PG8_SB
#undef PG8_STAGE
#undef PG8_LDA
#undef PG8_LDB
#undef PG8_MMA
#undef PG8_WAIT_V
#undef PG8_WAIT_L
#undef PG8_BAR
#undef PG8_SCHED
}
}

constexpr int NB = 4, SEQ = 4096, DM = 4096, FF = 11008, M = NB * SEQ;
constexpr int HD = 128, NHM = 16, NHS = 16, NKVS = 4, NMEM = 256, NHC = 4;
constexpr int MOBA_W = 2048, SWA_W = 2048, SWA_KV_W = 512, CROSS_W = 512, IN_W = 9216;
constexpr int COL_QM = 0, COL_KM = 2048, COL_VM = 4096, COL_QS = 6144, COL_KS = 8192, COL_VS = 8704;
constexpr float EPS = 1e-6f;
constexpr float LOG2E = 1.4426950408889634f;
constexpr float QK_C = 0.088388347648318440f * 1.4426950408889634f;
constexpr int NWAVES = 8;

constexpr size_t MiB = 1u << 20;
constexpr size_t WS_CTL = 0, CTL_ZERO_BYTES = 2 * MiB;
constexpr size_t WS_KMEAN = 1 * MiB;
constexpr size_t WS_KVC = 2 * MiB;
constexpr size_t WS_MEMN = 4 * MiB;
constexpr size_t WS_QC = 12 * MiB;
constexpr size_t WS_OC = 28 * MiB;
constexpr size_t WS_WCQ = 44 * MiB;
constexpr size_t WS_WCKV = 48 * MiB;
constexpr size_t WS_WCO = 56 * MiB;
constexpr size_t WS_WOUT = 60 * MiB;
constexpr size_t WS_WIN = 92 * MiB;
constexpr size_t WS_WGU1 = 164 * MiB;
constexpr size_t WS_WD1 = 336 * MiB;
constexpr size_t WS_WGU2 = 422 * MiB;
constexpr size_t WS_WD2 = 594 * MiB;
constexpr size_t WS_N = 680 * MiB;
constexpr size_t WS_H = 808 * MiB;
constexpr size_t WS_END = 1152 * MiB;
constexpr int CW_BAR = 4096;

constexpr int RING_OFF = 0, RING_BYTES = 131072;
constexpr int LDSCTL_OFF = RING_BYTES, MISC_OFF = LDSCTL_OFF + 320;
constexpr int LDS_BYTES = 147456;

#define GAS __attribute__((address_space(1)))
#define LAS __attribute__((address_space(3)))
typedef unsigned short bf16;
typedef unsigned v4u __attribute__((ext_vector_type(4)));
typedef unsigned v2u __attribute__((ext_vector_type(2)));
typedef float f32x4 __attribute__((ext_vector_type(4)));
typedef short bf16x8 __attribute__((ext_vector_type(8)));
typedef short s16x4 __attribute__((ext_vector_type(4)));
typedef GAS unsigned gu32;
#define RLX_AGENT __ATOMIC_RELAXED, __HIP_MEMORY_SCOPE_AGENT
#define LDS_WAIT() asm volatile("s_waitcnt lgkmcnt(0)" ::: "memory")
#define VM_WAIT() asm volatile("s_waitcnt vmcnt(0)" ::: "memory")
__device__ __forceinline__ unsigned f2bf(float f) { unsigned u = __builtin_bit_cast(unsigned, f); return (u + 0x7fffu + ((u >> 16) & 1u)) >> 16; }
__device__ __forceinline__ unsigned pk2(float lo, float hi) { return f2bf(lo) | (f2bf(hi) << 16); }
__device__ __forceinline__ float bf_lo(unsigned w) { return __builtin_bit_cast(float, w << 16); }
__device__ __forceinline__ float bf_hi(unsigned w) { return __builtin_bit_cast(float, w & 0xffff0000u); }
#define XB_TMO      128
#define XB_XCNT(j)  (256  + 64 * (j))
#define XB_XSUB(j)  (1280 + 64 * (j))
#define XB_XGEN(j)  (2304 + 64 * (j))
#define XB_TOP      3328
#define XB_TOPGEN   3392
#define XCD_BAR_WORDS 3456
#define XB_SPIN_CAP (1u << 18)

__device__ __forceinline__ unsigned xb_ld(unsigned* p)              { return __hip_atomic_load(p, __ATOMIC_RELAXED, __HIP_MEMORY_SCOPE_AGENT); }
__device__ __forceinline__ unsigned xb_add(unsigned* p, unsigned v) { return __hip_atomic_fetch_add(p, v, __ATOMIC_RELAXED, __HIP_MEMORY_SCOPE_AGENT); }
__device__ __forceinline__ unsigned xb_xcc_id() { return (unsigned)__builtin_amdgcn_s_getreg((3 << 11) | 20) & 0xFu; }
#define XB_SPIN(cond, bar) do { unsigned _sp = 0; while (cond) { __builtin_amdgcn_s_sleep(1); \
    if ((++_sp & 255u) == 0u) { if (xb_ld(&(bar)[XB_TMO])) break; if (_sp > XB_SPIN_CAP) { atomicAdd(&(bar)[XB_TMO], 1u); break; } } } } while (0)

struct XcdBarrier {
    unsigned* bar; unsigned x;
    volatile LAS unsigned* st;
};

__device__ __forceinline__ XcdBarrier xcd_barrier_post(unsigned* bar, volatile LAS unsigned* st) {
    XcdBarrier b; b.bar = bar; b.x = xb_xcc_id(); b.st = st;
    if (threadIdx.x == 0) (void)xb_add(&bar[XB_XCNT(b.x)], 1u);
    return b;
}
__device__ __forceinline__ void xcd_barrier_complete(unsigned* bar, unsigned x, unsigned& nloc, unsigned& nx) {
    const unsigned G = gridDim.x * gridDim.y * gridDim.z;
    unsigned sum, cnt, mine, sp = 0u;
    for (;;) {
        sum = 0u; cnt = 0u; mine = 0u;
#pragma unroll
        for (unsigned j = 0; j < 16; ++j) { const unsigned c = xb_ld(&bar[XB_XCNT(j)]); sum += c; cnt += (c > 0u) ? 1u : 0u; mine = (j == x) ? c : mine; }
        if (sum == G) break;
        __builtin_amdgcn_s_sleep(1);
        if ((++sp & 255u) == 0u) { if (xb_ld(&bar[XB_TMO])) break; if (sp > XB_SPIN_CAP) { atomicAdd(&bar[XB_TMO], 1u); break; } }
    }
    nloc = mine > 0u ? mine : 1u; nx = cnt > 0u ? cnt : 1u;
}

__device__ __forceinline__ void xcd_barrier(const XcdBarrier& b) {
    asm volatile("s_waitcnt vmcnt(0)" ::: "memory");
    __syncthreads();
    if (threadIdx.x == 0) {
        unsigned* bar = b.bar;
        __builtin_amdgcn_s_waitcnt(0);
        unsigned nloc = b.st[0], nx = b.st[1];
        if (nloc == 0u) { xcd_barrier_complete(bar, b.x, nloc, nx); b.st[0] = nloc; b.st[1] = nx; }
        const unsigned old = xb_add(&bar[XB_XSUB(b.x)], 1u);
        const unsigned gen = old / nloc;
        if (old + 1u == (gen + 1u) * nloc) {
            __builtin_amdgcn_fence(__ATOMIC_RELEASE, "agent");
            asm volatile("s_waitcnt vmcnt(0)" ::: "memory");
            const unsigned og = xb_add(&bar[XB_TOP], 1u);
            const unsigned tg = og / nx;
            if (og + 1u == (tg + 1u) * nx) xb_add(&bar[XB_TOPGEN], 1u);
            else XB_SPIN(xb_ld(&bar[XB_TOPGEN]) == tg, bar);
            __builtin_amdgcn_fence(__ATOMIC_ACQUIRE, "agent");
            xb_add(&bar[XB_XGEN(b.x)], 1u);
            asm volatile("s_waitcnt vmcnt(0)" ::: "memory");
        } else {
            XB_SPIN(xb_ld(&bar[XB_XGEN(b.x)]) == gen, bar);
            __builtin_amdgcn_fence(__ATOMIC_ACQUIRE, "agent");
            asm volatile("s_waitcnt vmcnt(0)" ::: "memory");
        }
    }
    __syncthreads();
}

__device__ __forceinline__ float wave_sum(float v) {
#pragma unroll
    for (int o = 1; o < 64; o <<= 1) v += __shfl_xor(v, o);
    return v;
}
__device__ __forceinline__ void cvt_item(const float* W, int K, int N, bf16* WT, int grp, int gstride, int goff, LAS float* scr, int item, int lane) {
    const int nblk = N / 32, kb = item / nblk, nb = item % nblk, k0 = 64 * kb, n0 = 32 * nb;
    const int orow0 = (n0 / grp) * gstride + goff + (n0 % grp);
#pragma unroll 4
    for (int i = 0; i < 32; ++i) { const int kk = 2 * i + (lane >> 5); scr[kk * 33 + (lane & 31)] = W[(size_t)(k0 + kk) * N + n0 + (lane & 31)]; }
    LDS_WAIT(); asm volatile("" ::: "memory");
    const int c = lane & 7;
#pragma unroll
    for (int j = 0; j < 4; ++j) { const int n = (lane >> 3) + 8 * j; const LAS float* s = scr + (8 * c) * 33 + n;
        v4u o; o.x = pk2(s[0 * 33], s[1 * 33]); o.y = pk2(s[2 * 33], s[3 * 33]); o.z = pk2(s[4 * 33], s[5 * 33]); o.w = pk2(s[6 * 33], s[7 * 33]);
        *(v4u*)(WT + (size_t)(orow0 + n) * K + k0 + 8 * c) = o; }
    LDS_WAIT(); asm volatile("" ::: "memory");
}
__device__ __forceinline__ void rms_row_bf16(const float* xrow, const float* g, bf16* orow, int lane) {
    const f32x4* xr = (const f32x4*)xrow + lane;
    f32x4 v[16]; float s = 0.f;
#pragma unroll
    for (int j = 0; j < 16; ++j) { v[j] = xr[64 * j]; s += (v[j].x * v[j].x + v[j].y * v[j].y) + (v[j].z * v[j].z + v[j].w * v[j].w); }
    const float rstd = 1.0f / sqrtf(wave_sum(s) * (1.f / DM) + EPS);
    const f32x4* gr = (const f32x4*)g + lane;
    v2u* o8 = (v2u*)orow + lane;
#pragma unroll
    for (int j = 0; j < 16; ++j) { const f32x4 gg = gr[64 * j]; v2u w; w.x = pk2(v[j].x * rstd * gg.x, v[j].y * rstd * gg.y); w.y = pk2(v[j].z * rstd * gg.z, v[j].w * rstd * gg.w); o8[64 * j] = w; }
}
__device__ __forceinline__ void cvt_item_f8(const float* W, int K, int N, unsigned char* WT, int grp, int gstride, int goff, float scale, LAS float* scr, int item, int lane) {
    const int nblk = N / 32, kb = item / nblk, nb = item % nblk, k0 = 64 * kb, n0 = 32 * nb;
    const int orow0 = (n0 / grp) * gstride + goff + (n0 % grp);
#pragma unroll 4
    for (int i = 0; i < 32; ++i) { const int kk = 2 * i + (lane >> 5); scr[kk * 33 + (lane & 31)] = W[(size_t)(k0 + kk) * N + n0 + (lane & 31)]; }
    LDS_WAIT(); asm volatile("" ::: "memory");
    const int c = lane & 3;
#pragma unroll
    for (int j = 0; j < 2; ++j) { const int n = (lane >> 2) + 16 * j; const LAS float* s = scr + (16 * c) * 33 + n;
        v4u o;
        o.x = pg8::pk4_fp8(s[0 * 33] * scale, s[1 * 33] * scale, s[2 * 33] * scale, s[3 * 33] * scale); o.y = pg8::pk4_fp8(s[4 * 33] * scale, s[5 * 33] * scale, s[6 * 33] * scale, s[7 * 33] * scale);
        o.z = pg8::pk4_fp8(s[8 * 33] * scale, s[9 * 33] * scale, s[10 * 33] * scale, s[11 * 33] * scale); o.w = pg8::pk4_fp8(s[12 * 33] * scale, s[13 * 33] * scale, s[14 * 33] * scale, s[15 * 33] * scale);
        *(v4u*)(WT + (size_t)(orow0 + n) * K + k0 + 16 * c) = o; }
    LDS_WAIT(); asm volatile("" ::: "memory");
}
__device__ __forceinline__ void rms_row_f8(const float* xrow, const float* g, unsigned char* orow, int lane) {
    const f32x4* xr = (const f32x4*)xrow + lane;
    f32x4 v[16]; float s = 0.f;
#pragma unroll
    for (int j = 0; j < 16; ++j) { v[j] = xr[64 * j]; s += (v[j].x * v[j].x + v[j].y * v[j].y) + (v[j].z * v[j].z + v[j].w * v[j].w); }
    const float rstd = 1.0f / sqrtf(wave_sum(s) * (1.f / DM) + EPS);
    const f32x4* gr = (const f32x4*)g + lane;
    unsigned* o4 = (unsigned*)orow + lane;
#pragma unroll
    for (int j = 0; j < 16; ++j) { const f32x4 gg = gr[64 * j]; o4[64 * j] = pg8::pk4_fp8(v[j].x * rstd * gg.x, v[j].y * rstd * gg.y, v[j].z * rstd * gg.z, v[j].w * rstd * gg.w); }
}
__device__ __forceinline__ void rms_row_f32(float* xrow, const float* g, int lane) {
    f32x4* xr = (f32x4*)xrow + lane;
    f32x4 v[16]; float s = 0.f;
#pragma unroll
    for (int j = 0; j < 16; ++j) { v[j] = xr[64 * j]; s += (v[j].x * v[j].x + v[j].y * v[j].y) + (v[j].z * v[j].z + v[j].w * v[j].w); }
    const float rstd = 1.0f / sqrtf(wave_sum(s) * (1.f / DM) + EPS);
    const f32x4* gr = (const f32x4*)g + lane;
#pragma unroll
    for (int j = 0; j < 16; ++j) { const f32x4 gg = gr[64 * j]; xr[64 * j] = v[j] * rstd * gg; }
}
__device__ __forceinline__ void onorm_row_f8(const bf16* orow, unsigned char* orow8, const float* gm, const float* gs, int lane) {
    const int half = lane >> 5, l32 = lane & 31;
    const v4u* p = (const v4u*)(orow + half * 2048) + l32;
    v4u v[8]; float s = 0.f;
#pragma unroll
    for (int j = 0; j < 8; ++j) { v[j] = p[32 * j];
#pragma unroll
        for (int e = 0; e < 4; ++e) { const float a = bf_lo(v[j][e]), b = bf_hi(v[j][e]); s += a * a + b * b; } }
#pragma unroll
    for (int o = 1; o < 32; o <<= 1) s += __shfl_xor(s, o);
    const float rstd = 1.0f / sqrtf(s * (1.f / 2048.f) + EPS);
    const float* g = half ? gs : gm;
    asm volatile("s_waitcnt vmcnt(0)" ::: "memory");
    v2u* q = (v2u*)(orow8 + half * 2048) + l32;
#pragma unroll
    for (int j = 0; j < 8; ++j) { const f32x4* gp = (const f32x4*)(g + (l32 + 32 * j) * 8); const f32x4 g0 = gp[0], g1 = gp[1]; v2u w;
        w.x = pg8::pk4_fp8(bf_lo(v[j].x) * rstd * g0.x, bf_hi(v[j].x) * rstd * g0.y, bf_lo(v[j].y) * rstd * g0.z, bf_hi(v[j].y) * rstd * g0.w);
        w.y = pg8::pk4_fp8(bf_lo(v[j].z) * rstd * g1.x, bf_hi(v[j].z) * rstd * g1.y, bf_lo(v[j].w) * rstd * g1.z, bf_hi(v[j].w) * rstd * g1.w);
        q[32 * j] = w; }
}

namespace att {
constexpr int KST = 272, VST = 288;
constexpr int K_OFF = 0, V_OFF = 64 * KST, TILE_BYTES = V_OFF + 64 * VST  , KM_OFF = 2 * TILE_BYTES, LUT_OFF = KM_OFF + 16 * 128 * 4, LUT_STRIDE = 132  , RED_OFF = LUT_OFF + 2 * LUT_STRIDE * 4, END_OFF = RED_OFF + 8 * 128 * 4;
constexpr float SM_THR = 8.f;
static_assert(END_OFF <= RING_BYTES && V_OFF % 16 == 0 && KM_OFF % 16 == 0 && TILE_BYTES % 16 == 0, "attention LDS map");

__device__ __forceinline__ int t5_bucket(int n) {
    if (n < 16) return n;
    return 16 + (n >= 19) + (n >= 21) + (n >= 24) + (n >= 27) + (n >= 31) + (n >= 35) + (n >= 40) + (n >= 46) + (n >= 52) + (n >= 59) + (n >= 67) + (n >= 77) + (n >= 87) + (n >= 99) + (n >= 113);
}
__device__ __forceinline__ float bf2f(short s) { return __builtin_bit_cast(float, ((unsigned)(unsigned short)s) << 16); }

__device__ __forceinline__ void kv_load(const bf16* Kg, const bf16* Vg, int ld, int tid, v4u (&kr)[2], v4u (&vr)[2]) {
#pragma unroll
    for (int i = 0; i < 2; ++i) { const int c = tid + 512 * i, row = c >> 4, col = (c & 15) * 8;
        kr[i] = *(const v4u*)(Kg + (size_t)row * ld + col); vr[i] = *(const v4u*)(Vg + (size_t)row * ld + col); }
}
__device__ __forceinline__ void kv_store(LAS unsigned char* L, int tid, const v4u (&kr)[2], const v4u (&vr)[2]) {
#pragma unroll
    for (int i = 0; i < 2; ++i) { const int c = tid + 512 * i, row = c >> 4, cb = (c & 15) * 16;
        *(LAS v4u*)(L + K_OFF + row * KST + cb) = kr[i]; *(LAS v4u*)(L + V_OFF + row * VST + cb) = vr[i]; }
}
__device__ __forceinline__ void q_load(const bf16* Qp, int ldq, int row0, int j, int g, bf16x8 (&qf)[2][4]) {
#pragma unroll
    for (int qg = 0; qg < 2; ++qg)
#pragma unroll
        for (int dd = 0; dd < 4; ++dd) qf[qg][dd] = *(const bf16x8*)(Qp + (size_t)(row0 + 16 * qg + j) * ldq + 32 * dd + 8 * g);
}
__device__ __forceinline__ void qk_tile(LAS unsigned char* L, const bf16x8 (&qf)[2][4], f32x4 (&t)[2][4], int j, int g) {
    const LAS unsigned char* base = L + K_OFF + j * KST + g * 16;
    bf16x8 kf[2][4];
#pragma unroll
    for (int dd = 0; dd < 4; ++dd) kf[0][dd] = *(const LAS bf16x8*)(base + dd * 64);
#pragma unroll
    for (int ks = 0; ks < 4; ++ks) {
        if (ks + 1 < 4) {
#pragma unroll
            for (int dd = 0; dd < 4; ++dd) kf[(ks + 1) & 1][dd] = *(const LAS bf16x8*)(base + (ks + 1) * 16 * KST + dd * 64); }
        __builtin_amdgcn_sched_barrier(0);
        __builtin_amdgcn_s_setprio(2);
        t[0][ks] = (f32x4){0.f, 0.f, 0.f, 0.f}; t[1][ks] = (f32x4){0.f, 0.f, 0.f, 0.f};
#pragma unroll
        for (int dd = 0; dd < 4; ++dd) {
            t[0][ks] = __builtin_amdgcn_mfma_f32_16x16x32_bf16(kf[ks & 1][dd], qf[0][dd], t[0][ks], 0, 0, 0);
            t[1][ks] = __builtin_amdgcn_mfma_f32_16x16x32_bf16(kf[ks & 1][dd], qf[1][dd], t[1][ks], 0, 0, 0); }
        __builtin_amdgcn_s_setprio(0);
        __builtin_amdgcn_sched_barrier(0); }
}
__device__ __forceinline__ void pv_tile(LAS unsigned char* L, const bf16x8 (&pf)[2][2], f32x4 (&o)[2][8], int lane) {
    const int g = lane >> 4, q_ = (lane & 15) >> 2, p_ = lane & 3;
    LAS unsigned char* base = L + V_OFF + (4 * g + q_) * VST + p_ * 8;
    s16x4 lo[2][2], hi[2][2];
#define PV_LOAD(buf, grp) do { _Pragma("unroll") for (int e = 0; e < 2; ++e) { const int kk_ = (grp) >> 2, ds_ = 2 * ((grp) & 3) + e; \
        lo[buf][e] = __builtin_amdgcn_ds_read_tr16_b64_v4i16((LAS s16x4*)(base + (32 * kk_) * VST + ds_ * 32)); \
        hi[buf][e] = __builtin_amdgcn_ds_read_tr16_b64_v4i16((LAS s16x4*)(base + (32 * kk_ + 16) * VST + ds_ * 32)); } } while (0)
    PV_LOAD(0, 0);
#pragma unroll
    for (int grp = 0; grp < 8; ++grp) {
        if (grp + 1 < 8) PV_LOAD((grp + 1) & 1, grp + 1);
        __builtin_amdgcn_sched_barrier(0);
        __builtin_amdgcn_s_setprio(2);
#pragma unroll
        for (int e = 0; e < 2; ++e) { const int kk = grp >> 2, ds = 2 * (grp & 3) + e; const s16x4 a = lo[grp & 1][e], c = hi[grp & 1][e];
            const bf16x8 vf = (bf16x8){a[0], a[1], a[2], a[3], c[0], c[1], c[2], c[3]};
            o[0][ds] = __builtin_amdgcn_mfma_f32_16x16x32_bf16(vf, pf[0][kk], o[0][ds], 0, 0, 0);
            o[1][ds] = __builtin_amdgcn_mfma_f32_16x16x32_bf16(vf, pf[1][kk], o[1][ds], 0, 0, 0); }
        __builtin_amdgcn_s_setprio(0);
        __builtin_amdgcn_sched_barrier(0); }
#undef PV_LOAD
}
__device__ __forceinline__ void sm_update(f32x4 (&t)[2][4], float (&m)[2], float (&l)[2], f32x4 (&o)[2][8], bf16x8 (&pf)[2][2]) {
    float mx[2];
#pragma unroll
    for (int qg = 0; qg < 2; ++qg) { float v = -INFINITY;
#pragma unroll
        for (int ks = 0; ks < 4; ++ks)
#pragma unroll
            for (int r = 0; r < 4; ++r) v = fmaxf(v, t[qg][ks][r]);
        v = fmaxf(v, __shfl_xor(v, 16)); v = fmaxf(v, __shfl_xor(v, 32)); mx[qg] = v; }
    const bool grow = (mx[0] > m[0] + SM_THR) || (mx[1] > m[1] + SM_THR);
    if (__any((int)grow)) {
#pragma unroll
        for (int qg = 0; qg < 2; ++qg) { const float mn = fmaxf(m[qg], mx[qg]); const float mref = (mn == -INFINITY) ? 0.f : mn;
            const float alpha = __builtin_amdgcn_exp2f(m[qg] - mref); l[qg] *= alpha; m[qg] = mn;
#pragma unroll
            for (int ds = 0; ds < 8; ++ds) o[qg][ds] = o[qg][ds] * alpha; }
    }
#pragma unroll
    for (int qg = 0; qg < 2; ++qg) { const float mref = (m[qg] == -INFINITY) ? 0.f : m[qg]; float ps = 0.f;
#pragma unroll
        for (int ks = 0; ks < 4; ++ks)
#pragma unroll
            for (int r = 0; r < 4; ++r) { const float p = __builtin_amdgcn_exp2f(t[qg][ks][r] - mref); t[qg][ks][r] = p; ps += p; }
        l[qg] += ps;
#pragma unroll
        for (int kk = 0; kk < 2; ++kk) { v4u w;
            w.x = pg8::cvt_pk_bf16(t[qg][2 * kk][0], t[qg][2 * kk][1]); w.y = pg8::cvt_pk_bf16(t[qg][2 * kk][2], t[qg][2 * kk][3]);
            w.z = pg8::cvt_pk_bf16(t[qg][2 * kk + 1][0], t[qg][2 * kk + 1][1]); w.w = pg8::cvt_pk_bf16(t[qg][2 * kk + 1][2], t[qg][2 * kk + 1][3]);
            pf[qg][kk] = __builtin_bit_cast(bf16x8, w); }
    }
}
__device__ __forceinline__ void o_store(bf16* Op, int ldo, int row0, float (&l)[2], f32x4 (&o)[2][8], int j, int g) {
#pragma unroll
    for (int qg = 0; qg < 2; ++qg) { float lt = l[qg]; lt += __shfl_xor(lt, 16); lt += __shfl_xor(lt, 32); const float inv = 1.0f / lt;
        bf16* rp = Op + (size_t)(row0 + 16 * qg + j) * ldo + 4 * g;
#pragma unroll
        for (int ds = 0; ds < 8; ++ds) { const f32x4 v = o[qg][ds] * inv; v2u w; w.x = pk2(v.x, v.y); w.y = pk2(v.z, v.w); *(v2u*)(rp + 16 * ds) = w; } }
}

__device__ __forceinline__ void moba_unit(LAS unsigned char* L, const bf16* proj, const float* kmean, const float* rel_bias, bf16* Ob, int b, int h, int qb, int tid_) {
    int tid = tid_; asm volatile("" : "+v"(tid));
    const int lane = tid & 63, wave = __builtin_amdgcn_readfirstlane(tid >> 6), j = lane & 15, g = lane >> 4;
    const bf16* Qp = proj + (size_t)(b * SEQ + 256 * qb) * IN_W + COL_QM + h * HD;
    const bf16* Kp = proj + (size_t)(b * SEQ) * IN_W + COL_KM + h * HD;
    const bf16* Vp = proj + (size_t)(b * SEQ) * IN_W + COL_VM + h * HD;
    bf16* Op = Ob + (size_t)(b * SEQ + 256 * qb) * DM + h * HD;
    const int ntiles = 4 + 4 * qb;
    __syncthreads();
    { const int idx = tid * 4, n = idx >> 7; f32x4 v = (f32x4){0.f, 0.f, 0.f, 0.f};
      if (n < qb) v = *(const f32x4*)(kmean + (size_t)((b * 16 + n) * 16 + h) * 128 + (idx & 127)) * (1.0f / 256.0f);
      *(LAS f32x4*)(L + KM_OFF + idx * 4) = v; }
    if (tid < 128) *(LAS float*)(L + LUT_OFF + tid * 4) = rel_bias[t5_bucket(tid) * 32 + h] * LOG2E;
    if (tid == 128) *(LAS float*)(L + LUT_OFF + 128 * 4) = -INFINITY;
    v4u kr[2], vr[2];
    kv_load(Kp + (size_t)(256 * qb) * IN_W, Vp + (size_t)(256 * qb) * IN_W, IN_W, tid, kr, vr);
    bf16x8 qf[2][4];
    q_load(Qp, IN_W, 32 * wave, j, g, qf);
    kv_store(L, tid, kr, vr);
    kv_load(Kp + (size_t)(256 * qb + 64) * IN_W, Vp + (size_t)(256 * qb + 64) * IN_W, IN_W, tid, kr, vr);
    __syncthreads();
    unsigned sel[2];
    {
        float v1[2] = {-INFINITY, -INFINITY}, v2[2] = {-INFINITY, -INFINITY}, v3[2] = {-INFINITY, -INFINITY}; int i1[2] = {-1, -1}, i2[2] = {-1, -1}, i3[2] = {-1, -1};
#pragma unroll 1
        for (int n = 0; n < qb; ++n) {
            float a[2] = {0.f, 0.f};
#pragma unroll
            for (int dd = 0; dd < 4; ++dd) { const LAS f32x4* kp = (const LAS f32x4*)(L + KM_OFF + (n * 128 + 32 * dd + 8 * g) * 4); const f32x4 ka = kp[0], kb = kp[1];
#pragma unroll
                for (int qg = 0; qg < 2; ++qg) { a[qg] += bf2f(qf[qg][dd][0]) * ka.x; a[qg] += bf2f(qf[qg][dd][1]) * ka.y; a[qg] += bf2f(qf[qg][dd][2]) * ka.z; a[qg] += bf2f(qf[qg][dd][3]) * ka.w;
                    a[qg] += bf2f(qf[qg][dd][4]) * kb.x; a[qg] += bf2f(qf[qg][dd][5]) * kb.y; a[qg] += bf2f(qf[qg][dd][6]) * kb.z; a[qg] += bf2f(qf[qg][dd][7]) * kb.w; } }
#pragma unroll
            for (int qg = 0; qg < 2; ++qg) { float v = a[qg]; v += __shfl_xor(v, 16); v += __shfl_xor(v, 32);
                const bool c1 = v > v1[qg], c2 = v > v2[qg], c3 = v > v3[qg];
                v3[qg] = c2 ? v2[qg] : (c3 ? v : v3[qg]); i3[qg] = c2 ? i2[qg] : (c3 ? n : i3[qg]);
                v2[qg] = c1 ? v1[qg] : (c2 ? v : v2[qg]); i2[qg] = c1 ? i1[qg] : (c2 ? n : i2[qg]);
                v1[qg] = c1 ? v : v1[qg];                 i1[qg] = c1 ? n : i1[qg]; }
        }
#pragma unroll
        for (int qg = 0; qg < 2; ++qg) sel[qg] = (i1[qg] >= 0 ? (1u << i1[qg]) : 0u) | (i2[qg] >= 0 ? (1u << i2[qg]) : 0u) | (i3[qg] >= 0 ? (1u << i3[qg]) : 0u);
    }
    float m[2] = {-INFINITY, -INFINITY}, l[2] = {0.f, 0.f}; f32x4 o[2][8];
#pragma unroll
    for (int qg = 0; qg < 2; ++qg)
#pragma unroll
        for (int ds = 0; ds < 8; ++ds) o[qg][ds] = (f32x4){0.f, 0.f, 0.f, 0.f};
    const LAS float* lut = (const LAS float*)(L + LUT_OFF);
    const float lutfar = lut[127];
#pragma unroll 1
    for (int it = 0; it < ntiles; ++it) {
        LAS unsigned char* Lb = L + (it & 1) * TILE_BYTES;
        if (it + 1 < ntiles) kv_store(L + ((it + 1) & 1) * TILE_BYTES, tid, kr, vr);
        const bool own = it < 4; const int n = own ? qb : ((it - 4) >> 2), kt = own ? it : ((it - 4) & 3);
        if (it + 2 < ntiles) { const int it2 = it + 2; const bool own2 = it2 < 4; const int n2 = own2 ? qb : ((it2 - 4) >> 2), kt2 = own2 ? it2 : ((it2 - 4) & 3);
            const size_t kro = (size_t)(256 * n2 + 64 * kt2) * IN_W; kv_load(Kp + kro, Vp + kro, IN_W, tid, kr, vr); }
        bool active;
        if (own) active = (64 * kt <= 32 * wave + 31);
        else active = __any((int)(((sel[0] | sel[1]) >> n) & 1u)) != 0;
        if (active) {
            f32x4 t[2][4];
            qk_tile(Lb, qf, t, j, g);
            const int dbase = 256 * (qb - n) - 64 * kt + 32 * wave;
            if ((dbase - 63) < 127) {
#pragma unroll
                for (int qg = 0; qg < 2; ++qg) { const bool selq = own || (((sel[qg] >> n) & 1u) != 0u);
#pragma unroll
                    for (int ks = 0; ks < 4; ++ks)
#pragma unroll
                        for (int r = 0; r < 4; ++r) { const int d = dbase + (16 * qg + j) - (16 * ks + 4 * g + r);
                            const int dc = (selq && d >= 0) ? (d > 127 ? 127 : d) : 128;
                            t[qg][ks][r] = fmaf(t[qg][ks][r], QK_C, lut[dc]); } }
            } else {
#pragma unroll
                for (int qg = 0; qg < 2; ++qg) { const float bq = (own || (((sel[qg] >> n) & 1u) != 0u)) ? lutfar : -INFINITY;
#pragma unroll
                    for (int ks = 0; ks < 4; ++ks)
#pragma unroll
                        for (int r = 0; r < 4; ++r) t[qg][ks][r] = fmaf(t[qg][ks][r], QK_C, bq); }
            }
            bf16x8 pf[2][2];
            sm_update(t, m, l, o, pf);
            pv_tile(Lb, pf, o, lane);
        }
        __syncthreads();
    }
    o_store(Op, DM, 32 * wave, l, o, j, g);
}

__device__ __forceinline__ void swa_unit(LAS unsigned char* L, const bf16* proj, const float* rel_bias, const float* sinks, bf16* Ob, int b, int kvh, int i, int p, int tid_) {
    int tid = tid_; asm volatile("" : "+v"(tid));
    const int lane = tid & 63, wave = __builtin_amdgcn_readfirstlane(tid >> 6);
    const int j = lane & 15, g = lane >> 4, w4 = wave & 3, hq = 4 * kvh + 2 * p + (wave >> 2);
    const bf16* Qp = proj + (size_t)(b * SEQ + 128 * i) * IN_W + COL_QS + hq * HD;
    const bf16* Kp = proj + (size_t)(b * SEQ) * IN_W + COL_KS + kvh * HD;
    const bf16* Vp = proj + (size_t)(b * SEQ) * IN_W + COL_VS + kvh * HD;
    bf16* Op = Ob + (size_t)(b * SEQ + 128 * i) * DM + MOBA_W + hq * HD;
    const int kt0 = (i == 0) ? 2 : 0;
    __syncthreads();
    if (tid < 256) { const int hh = 4 * kvh + 2 * p + (tid >> 7), d = tid & 127; *(LAS float*)(L + LUT_OFF + ((tid >> 7) * LUT_STRIDE + d) * 4) = rel_bias[t5_bucket(d) * 32 + 16 + hh] * LOG2E; }
    if (tid >= 256 && tid < 258) *(LAS float*)(L + LUT_OFF + ((tid - 256) * LUT_STRIDE + 128) * 4) = -INFINITY;
    v4u kr[2], vr[2];
    { const long kro = (long)(128 * (i - 1) + 64 * kt0) * IN_W; kv_load(Kp + kro, Vp + kro, IN_W, tid, kr, vr); }
    bf16x8 qf[2][4];
    q_load(Qp, IN_W, 32 * w4, j, g, qf);
    kv_store(L + (kt0 & 1) * TILE_BYTES, tid, kr, vr);
    { const long kro = (long)(128 * (i - 1) + 64 * (kt0 + 1)) * IN_W; kv_load(Kp + kro, Vp + kro, IN_W, tid, kr, vr); }
    __syncthreads();
    const float sk = sinks[hq] * LOG2E;
    float m[2] = {sk, sk}, l[2] = {g == 0 ? 1.f : 0.f, g == 0 ? 1.f : 0.f}; f32x4 o[2][8];
#pragma unroll
    for (int qg = 0; qg < 2; ++qg)
#pragma unroll
        for (int ds = 0; ds < 8; ++ds) o[qg][ds] = (f32x4){0.f, 0.f, 0.f, 0.f};
    const LAS float* lut = (const LAS float*)(L + LUT_OFF) + LUT_STRIDE * (wave >> 2);
#pragma unroll 1
    for (int kt = kt0; kt < 4; ++kt) {
        LAS unsigned char* Lb = L + (kt & 1) * TILE_BYTES;
        if (kt + 1 < 4) kv_store(L + ((kt + 1) & 1) * TILE_BYTES, tid, kr, vr);
        if (kt + 2 < 4) { const long kro = (long)(128 * (i - 1) + 64 * (kt + 2)) * IN_W; kv_load(Kp + kro, Vp + kro, IN_W, tid, kr, vr); }
        const int dbase = 128 + 32 * w4 - 64 * kt;
        const bool active = (dbase + 31 >= 0) && (dbase - 63 <= 127);
        if (active) {
            f32x4 t[2][4];
            qk_tile(Lb, qf, t, j, g);
#pragma unroll
            for (int qg = 0; qg < 2; ++qg)
#pragma unroll
                for (int ks = 0; ks < 4; ++ks)
#pragma unroll
                    for (int r = 0; r < 4; ++r) { const int d = dbase + (16 * qg + j) - (16 * ks + 4 * g + r);
                        const int dc = ((unsigned)d < 128u) ? d : 128;
                        t[qg][ks][r] = fmaf(t[qg][ks][r], QK_C, lut[dc]); }
            bf16x8 pf[2][2];
            sm_update(t, m, l, o, pf);
            pv_tile(Lb, pf, o, lane);
        }
        __syncthreads();
    }
    o_store(Op, DM, 32 * w4, l, o, j, g);
}

__device__ __forceinline__ void cross_unit(LAS unsigned char* L, const bf16* qc, const bf16* kvc, bf16* oc, int b, int hc, int qt, int tid_) {
    int tid = tid_; asm volatile("" : "+v"(tid));
    const int lane = tid & 63, wave = __builtin_amdgcn_readfirstlane(tid >> 6), j = lane & 15, g = lane >> 4;
    const bf16* Qp = qc + (size_t)(b * SEQ + 256 * qt) * CROSS_W + hc * HD;
    const bf16* Kp = kvc + (size_t)(b * NMEM) * 1024 + hc * HD;
    const bf16* Vp = Kp + 512;
    bf16* Op = oc + (size_t)(b * SEQ + 256 * qt) * CROSS_W + hc * HD;
    __syncthreads();
    v4u kr[2], vr[2];
    kv_load(Kp, Vp, 1024, tid, kr, vr);
    bf16x8 qf[2][4];
    q_load(Qp, CROSS_W, 32 * wave, j, g, qf);
    kv_store(L, tid, kr, vr);
    kv_load(Kp + (size_t)64 * 1024, Vp + (size_t)64 * 1024, 1024, tid, kr, vr);
    __syncthreads();
    float m[2] = {-INFINITY, -INFINITY}, l[2] = {0.f, 0.f}; f32x4 o[2][8];
#pragma unroll
    for (int qg = 0; qg < 2; ++qg)
#pragma unroll
        for (int ds = 0; ds < 8; ++ds) o[qg][ds] = (f32x4){0.f, 0.f, 0.f, 0.f};
#pragma unroll 1
    for (int kt = 0; kt < 4; ++kt) {
        LAS unsigned char* Lb = L + (kt & 1) * TILE_BYTES;
        if (kt + 1 < 4) kv_store(L + ((kt + 1) & 1) * TILE_BYTES, tid, kr, vr);
        if (kt + 2 < 4) { const size_t kro = (size_t)(64 * (kt + 2)) * 1024; kv_load(Kp + kro, Vp + kro, 1024, tid, kr, vr); }
        f32x4 t[2][4];
        qk_tile(Lb, qf, t, j, g);
#pragma unroll
        for (int qg = 0; qg < 2; ++qg)
#pragma unroll
            for (int ks = 0; ks < 4; ++ks) t[qg][ks] = t[qg][ks] * QK_C;
        bf16x8 pf[2][2];
        sm_update(t, m, l, o, pf);
        pv_tile(Lb, pf, o, lane);
        __syncthreads();
    }
    o_store(Op, CROSS_W, 32 * wave, l, o, j, g);
}

}

enum Phase { PH_PRO = 0, PH_GU1, PH_DN1, PH_NORM2, PH_WIN, PH_KMEAN, PH_ATTN, PH_ONORM, PH_WOUT, PH_NORM3, PH_CQ, PH_CATTN, PH_CO, PH_NORM4, PH_GU2, PH_DN2, PH_FINAL, NPH };
enum In { I_X = 0, I_MEM, I_RELB, I_GFINAL, I_GFFN1, I_W1G, I_W1U, I_W1D, I_GMIX, I_WIN, I_BIN, I_SINKS, I_GOM, I_GOS, I_WOUT, I_GCROSS, I_GMEM, I_WCQ, I_WCK, I_WCV, I_WCO, I_GFFN2, I_W2G, I_W2U, I_W2D, N_IN };
struct Args { const float* in[N_IN]; float* out; unsigned char* ws; int ph_lo, ph_hi; };
static_assert(sizeof(Args) == N_IN * 8 + 8 + 8 + 8, "Args has no padding bytes");

constexpr float W2GU_SCALE = 64.f, W2D_SCALE = 128.f, H2_SCALE = 8.f, WOUT_SCALE = 64.f, WCQ_SCALE = 64.f;
#define PG8_ALIGN true
#define PG8_SP2 true

__global__ void __launch_bounds__(NWAVES * 64, 2) hymba_fwd(Args args) {
    extern __shared__ __attribute__((aligned(16))) unsigned char lds[];
    LAS unsigned char* L = (LAS unsigned char*)lds;
    volatile LAS unsigned* MISC = (volatile LAS unsigned*)(L + MISC_OFF);
    const int tid = threadIdx.x, lane = tid & 63, wave = __builtin_amdgcn_readfirstlane(tid >> 6);
    const int G = gridDim.x, bid = blockIdx.x;
    unsigned char* ws = args.ws;
    gu32* ctl = (gu32*)(ws + WS_CTL);
    float* xs = args.out;
    float* kmean = (float*)(ws + WS_KMEAN);
    bf16* kvc = (bf16*)(ws + WS_KVC); bf16* memn = (bf16*)(ws + WS_MEMN); bf16* qc = (bf16*)(ws + WS_QC); bf16* oc = (bf16*)(ws + WS_OC);
    bf16* Wcq = (bf16*)(ws + WS_WCQ); bf16* Wckv = (bf16*)(ws + WS_WCKV); bf16* Wco = (bf16*)(ws + WS_WCO); bf16* Wout = (bf16*)(ws + WS_WOUT); bf16* Win = (bf16*)(ws + WS_WIN);
    bf16* Wgu1 = (bf16*)(ws + WS_WGU1); bf16* Wd1 = (bf16*)(ws + WS_WD1); bf16* Wgu2 = (bf16*)(ws + WS_WGU2); bf16* Wd2 = (bf16*)(ws + WS_WD2);
    bf16* NB_ = (bf16*)(ws + WS_N); bf16* HB = (bf16*)(ws + WS_H); bf16* PROJ = (bf16*)(ws + WS_H);
    for (int u = tid; u < (LDS_BYTES - LDSCTL_OFF) / 4; u += NWAVES * 64) ((LAS unsigned*)(L + LDSCTL_OFF))[u] = 0u;
    __syncthreads();
    const int lo = args.ph_lo, hi = args.ph_hi;
    const bool use_bar = (hi - lo) > 1;
    XcdBarrier bar; bar.bar = (unsigned*)(ctl + CW_BAR); bar.x = 0; bar.st = nullptr;
    if (use_bar) bar = xcd_barrier_post((unsigned*)(ctl + CW_BAR), MISC + 8);
#ifndef PH_MASK
#define PH_MASK 0xFFFFFFFFu
#endif
#define IN(k) ((((PH_MASK) >> (k)) & 1u) && lo <= (k) && (k) < hi)
#ifndef DUP_MASK
#define DUP_MASK 0u
#endif
#define REPS(k) ((((DUP_MASK) >> (k)) & 1u) ? 2 : 1)
#define SEAM(k) do { if (IN(k) && IN((k) + 1)) xcd_barrier(bar); } while (0)
    const int gw = bid * NWAVES + wave, NGW = G * NWAVES;

    if (IN(PH_PRO)) _Pragma("unroll") for (int rep_ = 0; rep_ < REPS(PH_PRO); ++rep_) { if (rep_) xcd_barrier(bar);
        LAS float* scr = (LAS float*)(L + RING_OFF + wave * 16384);
        constexpr int I_FF = (DM / 64) * (FF / 32);
        constexpr int I_IN = (DM / 64) * (IN_W / 32), I_OUT = (DM / 64) * (DM / 32), I_C = (DM / 64) * (CROSS_W / 32), I_CO = (CROSS_W / 64) * (DM / 32);
        constexpr int NITEMS = 6 * I_FF + I_IN + I_OUT + 3 * I_C + I_CO;
        for (int it = gw; it < NITEMS; it += NGW) {
            int r = it;
            if (r < I_FF) { cvt_item(args.in[I_W1G], DM, FF, Wgu1, 128, 256, 0, scr, r, lane); continue; } r -= I_FF;
            if (r < I_FF) { cvt_item(args.in[I_W1U], DM, FF, Wgu1, 128, 256, 128, scr, r, lane); continue; } r -= I_FF;
            if (r < I_FF) { cvt_item(args.in[I_W1D], FF, DM, Wd1, DM, 0, 0, scr, r, lane); continue; } r -= I_FF;
            if (r < I_IN) { cvt_item(args.in[I_WIN], DM, IN_W, Win, IN_W, 0, 0, scr, r, lane); continue; } r -= I_IN;
            if (r < I_OUT) { cvt_item_f8(args.in[I_WOUT], DM, DM, (unsigned char*)Wout, DM, 0, 0, WOUT_SCALE, scr, r, lane); continue; } r -= I_OUT;
            if (r < I_C) { cvt_item_f8(args.in[I_WCQ], DM, CROSS_W, (unsigned char*)Wcq, CROSS_W, 0, 0, WCQ_SCALE, scr, r, lane); continue; } r -= I_C;
            if (r < I_C) { cvt_item(args.in[I_WCK], DM, CROSS_W, Wckv, CROSS_W, 0, 0, scr, r, lane); continue; } r -= I_C;
            if (r < I_C) { cvt_item(args.in[I_WCV], DM, CROSS_W, Wckv, CROSS_W, 0, 512, scr, r, lane); continue; } r -= I_C;
            if (r < I_CO) { cvt_item(args.in[I_WCO], CROSS_W, DM, Wco, DM, 0, 0, scr, r, lane); continue; } r -= I_CO;
            if (r < I_FF) { cvt_item_f8(args.in[I_W2G], DM, FF, (unsigned char*)Wgu2, 128, 256, 0, W2GU_SCALE, scr, r, lane); continue; } r -= I_FF;
            if (r < I_FF) { cvt_item_f8(args.in[I_W2U], DM, FF, (unsigned char*)Wgu2, 128, 256, 128, W2GU_SCALE, scr, r, lane); continue; } r -= I_FF;
            cvt_item_f8(args.in[I_W2D], FF, DM, (unsigned char*)Wd2, DM, 0, 0, W2D_SCALE, scr, r, lane);
        }
        for (int m = gw; m < M; m += NGW) rms_row_bf16(args.in[I_X] + (size_t)m * DM, args.in[I_GFFN1], NB_ + (size_t)m * DM, lane);
        for (int m = gw; m < NB * NMEM; m += NGW) rms_row_bf16(args.in[I_MEM] + (size_t)m * DM, args.in[I_GMEM], memn + (size_t)m * DM, lane);
        __syncthreads();
    }
    SEAM(PH_PRO);

    if (IN(PH_GU1)) _Pragma("unroll") for (int rep_ = 0; rep_ < REPS(PH_GU1); ++rep_) { if (rep_) xcd_barrier(bar);
        { pg8::Gemm g{NB_, Wgu1, M, 2 * FF, DM}; pg8::StaticOrder S; S.init(M, 2 * FF, G, bid);
          pg8::EpiSwiGLU E{HB, FF};
          pg8::gemm_phase<pg8::EpiSwiGLU, pg8::StaticOrder, PG8_ALIGN, PG8_SP2>(L + RING_OFF, g, S, E); }
        { const int rem = ((M / 256) * (2 * FF / 256)) % G; const int c2 = (bid >= rem) ? bid - rem : bid + (G - rem);
          pg8::Gemm g{memn, Wckv, NB * NMEM, 1024, DM}; pg8::StaticOrder S; S.init(NB * NMEM, 1024, G, c2);
          pg8::EpiBf16B E{kvc, 1024, nullptr, 1.0f};
          pg8::gemm_phase<pg8::EpiBf16B, pg8::StaticOrder, PG8_ALIGN, PG8_SP2>(L + RING_OFF, g, S, E); }
    }
    SEAM(PH_GU1);

    if (IN(PH_DN1)) _Pragma("unroll") for (int rep_ = 0; rep_ < REPS(PH_DN1); ++rep_) { if (rep_) xcd_barrier(bar);
        pg8::Gemm g{HB, Wd1, M, DM, FF}; pg8::StaticOrder S; S.init(M, DM, G, bid);
        pg8::EpiResF32 E{args.in[I_X], xs, DM, 0.5f};
        pg8::gemm_phase<pg8::EpiResF32, pg8::StaticOrder, PG8_ALIGN, PG8_SP2>(L + RING_OFF, g, S, E);
    }
    SEAM(PH_DN1);

    if (IN(PH_NORM2)) _Pragma("unroll") for (int rep_ = 0; rep_ < REPS(PH_NORM2); ++rep_) { if (rep_) xcd_barrier(bar); for (int m = gw; m < M; m += NGW) rms_row_bf16(xs + (size_t)m * DM, args.in[I_GMIX], NB_ + (size_t)m * DM, lane); }
    SEAM(PH_NORM2);

    if (IN(PH_WIN)) _Pragma("unroll") for (int rep_ = 0; rep_ < REPS(PH_WIN); ++rep_) { if (rep_) xcd_barrier(bar);
        pg8::Gemm g{NB_, Win, M, IN_W, DM}; pg8::StaticOrder S; S.init(M, IN_W, G, bid);
        pg8::EpiProj E{PROJ, IN_W, args.in[I_BIN], kmean, COL_KM};
        pg8::gemm_phase<pg8::EpiProj, pg8::StaticOrder, PG8_ALIGN, PG8_SP2>(L + RING_OFF, g, S, E);
    }
    SEAM(PH_WIN);


    if (IN(PH_ATTN)) _Pragma("unroll") for (int rep_ = 0; rep_ < REPS(PH_ATTN); ++rep_) { if (rep_) xcd_barrier(bar);
        for (int c = bid; c < 256; c += G) {
#ifndef NO_MOBA
            { const int b = c >> 6, h = (c >> 2) & 15, r = c & 3;
#pragma unroll 1
              for (int q = 0; q < 4; ++q) { const int qb = (q == 0) ? 15 - r : (q == 1) ? 11 - r : (q == 2) ? 4 + r : r;
                  att::moba_unit(L, PROJ, kmean, args.in[I_RELB], NB_, b, h, qb, tid); } }
#endif
#ifndef NO_SWA
            { const int b = c >> 6, kvh = (c >> 4) & 3, ib = c & 15;
#pragma unroll 1
              for (int q = 0; q < 4; ++q) att::swa_unit(L, PROJ, args.in[I_RELB], args.in[I_SINKS], NB_, b, kvh, 2 * ib + (q >> 1), q & 1, tid); }
#endif
        }
        __syncthreads();
    }
    SEAM(PH_ATTN);

    if (IN(PH_ONORM)) _Pragma("unroll") for (int rep_ = 0; rep_ < REPS(PH_ONORM); ++rep_) { if (rep_) xcd_barrier(bar); for (int m = gw; m < M; m += NGW) onorm_row_f8(NB_ + (size_t)m * DM, (unsigned char*)HB + (size_t)m * DM, args.in[I_GOM], args.in[I_GOS], lane); }
    SEAM(PH_ONORM);

    if (IN(PH_WOUT)) _Pragma("unroll") for (int rep_ = 0; rep_ < REPS(PH_WOUT); ++rep_) { if (rep_) xcd_barrier(bar);
        pg8::Gemm g{HB, Wout, M, DM, DM}; pg8::StaticOrder S; S.init(M, DM, G, bid);
        pg8::EpiResF32 E{xs, xs, DM, 1.0f / WOUT_SCALE};
        pg8::gemm_phase<pg8::EpiResF32, pg8::StaticOrder, PG8_ALIGN, PG8_SP2, true>(L + RING_OFF, g, S, E);
    }
    SEAM(PH_WOUT);

    if (IN(PH_NORM3)) _Pragma("unroll") for (int rep_ = 0; rep_ < REPS(PH_NORM3); ++rep_) { if (rep_) xcd_barrier(bar); for (int m = gw; m < M; m += NGW) rms_row_f8(xs + (size_t)m * DM, args.in[I_GCROSS], (unsigned char*)NB_ + (size_t)m * DM, lane); }
    SEAM(PH_NORM3);

    if (IN(PH_CQ)) _Pragma("unroll") for (int rep_ = 0; rep_ < REPS(PH_CQ); ++rep_) { if (rep_) xcd_barrier(bar);
        pg8::Gemm g{NB_, Wcq, M, CROSS_W, DM}; pg8::StaticOrder S; S.init(M, CROSS_W, G, bid);
        pg8::EpiBf16B E{qc, CROSS_W, nullptr, 1.0f / WCQ_SCALE};
        pg8::gemm_phase<pg8::EpiBf16B, pg8::StaticOrder, PG8_ALIGN, PG8_SP2, true>(L + RING_OFF, g, S, E);
    }
    SEAM(PH_CQ);

    if (IN(PH_CATTN)) _Pragma("unroll") for (int rep_ = 0; rep_ < REPS(PH_CATTN); ++rep_) { if (rep_) xcd_barrier(bar);
        for (int c = bid; c < 256; c += G) att::cross_unit(L, qc, kvc, oc, c >> 6, (c >> 4) & 3, c & 15, tid);
        __syncthreads();
    }
    SEAM(PH_CATTN);

    if (IN(PH_CO)) _Pragma("unroll") for (int rep_ = 0; rep_ < REPS(PH_CO); ++rep_) { if (rep_) xcd_barrier(bar);
        pg8::Gemm g{oc, Wco, M, DM, CROSS_W}; pg8::StaticOrder S; S.init(M, DM, G, bid);
        pg8::EpiResF32 E{xs, xs, DM, 1.0f};
        pg8::gemm_phase<pg8::EpiResF32, pg8::StaticOrder, PG8_ALIGN, PG8_SP2>(L + RING_OFF, g, S, E);
    }
    SEAM(PH_CO);

    if (IN(PH_NORM4)) _Pragma("unroll") for (int rep_ = 0; rep_ < REPS(PH_NORM4); ++rep_) { if (rep_) xcd_barrier(bar); for (int m = gw; m < M; m += NGW) rms_row_f8(xs + (size_t)m * DM, args.in[I_GFFN2], (unsigned char*)NB_ + (size_t)m * DM, lane); }
    SEAM(PH_NORM4);

    if (IN(PH_GU2)) _Pragma("unroll") for (int rep_ = 0; rep_ < REPS(PH_GU2); ++rep_) { if (rep_) xcd_barrier(bar);
        pg8::Gemm g{NB_, Wgu2, M, 2 * FF, DM}; pg8::StaticOrder S; S.init(M, 2 * FF, G, bid);
        pg8::EpiSwiGLUF8 E{(unsigned char*)HB, FF, 1.0f / W2GU_SCALE, H2_SCALE};
        pg8::gemm_phase<pg8::EpiSwiGLUF8, pg8::StaticOrder, PG8_ALIGN, PG8_SP2, true>(L + RING_OFF, g, S, E);
    }
    SEAM(PH_GU2);

    if (IN(PH_DN2)) _Pragma("unroll") for (int rep_ = 0; rep_ < REPS(PH_DN2); ++rep_) { if (rep_) xcd_barrier(bar);
        pg8::Gemm g{HB, Wd2, M, DM, FF}; pg8::StaticOrder S; S.init(M, DM, G, bid);
        pg8::EpiResF32 E{xs, xs, DM, 0.5f / (W2D_SCALE * H2_SCALE)};
        pg8::gemm_phase<pg8::EpiResF32, pg8::StaticOrder, PG8_ALIGN, PG8_SP2, true>(L + RING_OFF, g, S, E);
    }
    SEAM(PH_DN2);

    if (IN(PH_FINAL)) _Pragma("unroll") for (int rep_ = 0; rep_ < REPS(PH_FINAL); ++rep_) { if (rep_) xcd_barrier(bar); for (int m = gw; m < M; m += NGW) rms_row_f32(xs + (size_t)m * DM, args.in[I_GFINAL], lane); }
#undef IN
#undef SEAM
}

#ifndef MK_ONE_LAUNCH
#define MK_ONE_LAUNCH 1
#endif
extern "C" void kernel_launch(void* const* d_in, const int* in_sizes, int n_in, void* d_out, int out_size, void* d_ws, size_t ws_size, hipStream_t stream) {
    static int grid = 0;
    if (grid == 0) {
        if (n_in != N_IN || in_sizes[0] != M * DM || out_size != M * DM || ws_size < WS_END) { fprintf(stderr, "kernel_launch: unexpected shapes / workspace (n_in %d, in0 %d, out %d, ws %zu); nothing launched\n", n_in, n_in > 0 ? in_sizes[0] : -1, out_size, ws_size); grid = -1; return; }
        int dev = 0, cus = 0, per_cu = 0;
        if (hipGetDevice(&dev) != hipSuccess || hipDeviceGetAttribute(&cus, hipDeviceAttributeMultiprocessorCount, dev) != hipSuccess) { fprintf(stderr, "kernel_launch: hipGetDevice / hipDeviceGetAttribute failed\n"); grid = -1; return; }
        if (hipFuncSetAttribute((const void*)hymba_fwd, hipFuncAttributeMaxDynamicSharedMemorySize, LDS_BYTES) != hipSuccess) { fprintf(stderr, "kernel_launch: hipFuncSetAttribute failed\n"); grid = -1; return; }
        if (hipOccupancyMaxActiveBlocksPerMultiprocessor(&per_cu, (const void*)hymba_fwd, NWAVES * 64, LDS_BYTES) != hipSuccess || per_cu < 1) { fprintf(stderr, "kernel_launch: occupancy query reports %d workgroups per CU\n", per_cu); }
        (void)hipGetLastError();
        grid = cus;
    }
    if (grid < 0) return;
    (void)hipMemsetAsync((char*)d_ws + WS_CTL, 0, CTL_ZERO_BYTES, stream);
    Args a{};
    for (int i = 0; i < N_IN; ++i) a.in[i] = (const float*)d_in[i];
    a.out = (float*)d_out; a.ws = (unsigned char*)d_ws;
#if MK_ONE_LAUNCH
    a.ph_lo = 0; a.ph_hi = NPH;
    hipLaunchKernelGGL(hymba_fwd, dim3(grid), dim3(NWAVES * 64), LDS_BYTES, stream, a);
#else
    for (int ph = 0; ph < NPH; ++ph) { a.ph_lo = ph; a.ph_hi = ph + 1; hipLaunchKernelGGL(hymba_fwd, dim3(grid), dim3(NWAVES * 64), LDS_BYTES, stream, a); }
#endif
}
```

```cpp
#include <hip/hip_runtime.h>
#include <cstdio>
#include <cstdint>
#include <cmath>
namespace pg8 {
#define PG8_LAS __attribute__((address_space(3)))
typedef unsigned short bf16_t;
typedef short bf16x8 __attribute__((ext_vector_type(8)));
typedef float f32x4 __attribute__((ext_vector_type(4)));
typedef unsigned u32x4 __attribute__((ext_vector_type(4)));
constexpr int BM = 256, BK = 64, HALF = 128, HTB = HALF * BK * 2  , STAGE_BYTES = 8 * HTB, NXCD = 8, WGM = 8;

__host__ __device__ __forceinline__ int lds_byte(int r, int c) { const int st = (r >> 4) * 2 + (c >> 5), rr = r & 15, cc = c & 31, ob = rr * 64 + cc * 2; return st * 1024 + (ob ^ (((ob >> 9) & 1) << 5)); }
__host__ __device__ __forceinline__ void stage_rc(int b, int& R, int& C) { const int st = b / 1024, sb = b % 1024, swz = sb ^ (((sb >> 9) & 1) << 5); R = (st >> 1) * 16 + swz / 64; C = (st & 1) * 32 + (swz % 64) / 2; }
__host__ __device__ __forceinline__ int perm32(int rho) { const int n = rho >> 4, i = rho & 15; return 8 * (i >> 2) + 4 * n + (i & 3); }

struct Unit { int pm, pn; };
struct Gemm { const bf16_t* A; const bf16_t* Bt; int M, N, K; };

struct StaticOrder {
    int nM, nN, nwg, G, c;
    __host__ __device__ void init(int M, int N, int G_, int c_) { nM = M / BM; nN = N / BM; nwg = nM * nN; G = G_; c = c_; }
    __host__ __device__ bool next(int i, Unit& u) const {
        const long L = (long)i * G + c; if (L >= nwg) return false;
        int wgid = (int)L; { const int q = nwg / NXCD, r = nwg % NXCD, xcd = wgid % NXCD, off = wgid / NXCD; wgid = (xcd < r ? xcd * (q + 1) : r * (q + 1) + (xcd - r) * q) + off; }
        const int nig = WGM * nN, gid = wgid / nig, fm = gid * WGM, gsz = (nM - fm) < WGM ? (nM - fm) : WGM;
        u.pm = fm + ((wgid % nig) % gsz); u.pn = (wgid % nig) / gsz; return true;
    }
    __device__ __forceinline__ void a_ready(const Unit&) const {}
    __device__ __forceinline__ void done(const Unit&) const {}
};

__device__ __forceinline__ unsigned cvt_pk_bf16(float lo, float hi) { unsigned r; asm volatile("v_cvt_pk_bf16_f32 %0, %1, %2" : "=v"(r) : "v"(lo), "v"(hi)); return r; }
typedef float f32x2 __attribute__((ext_vector_type(2)));

struct EpiBf16B {
    static constexpr bool PERM = true, AFTER_DRAIN = false;
    bf16_t* O; int ldc; const float* bias; float sc;
    __device__ __forceinline__ void operator()(const f32x4 (&acc)[2][2][4][2], const Unit& u, int wr, int wc, int fr, int fq) const {
        const int row0 = u.pm * BM + wr * 64 + fr, col0 = u.pn * BM + wc * 32 + 8 * fq;
        f32x4 bv[2][2];
#pragma unroll
        for (int bj = 0; bj < 2; ++bj)
#pragma unroll
            for (int n = 0; n < 2; ++n) bv[bj][n] = bias ? *(const f32x4*)(bias + col0 + bj * HALF + 4 * n) : (f32x4){0.f, 0.f, 0.f, 0.f};
#pragma unroll
        for (int ai = 0; ai < 2; ++ai)
#pragma unroll
            for (int m = 0; m < 4; ++m) { bf16_t* rowp = O + (size_t)(row0 + ai * HALF + m * 16) * ldc + col0;
#pragma unroll
                for (int bj = 0; bj < 2; ++bj) { const f32x4 v0 = acc[ai][bj][m][0] * sc + bv[bj][0], v1 = acc[ai][bj][m][1] * sc + bv[bj][1];
                    u32x4 w; w.x = cvt_pk_bf16(v0[0], v0[1]); w.y = cvt_pk_bf16(v0[2], v0[3]); w.z = cvt_pk_bf16(v1[0], v1[1]); w.w = cvt_pk_bf16(v1[2], v1[3]);
                    *(u32x4*)(rowp + bj * HALF) = w; } }
    }
};
__device__ __forceinline__ float silu_mul(float g, float u) { const float e = __builtin_amdgcn_exp2f(g * -1.4426950408889634f); return g * __builtin_amdgcn_rcpf(1.0f + e) * u; }
struct EpiSwiGLU {
    static constexpr bool PERM = true, AFTER_DRAIN = false;
    bf16_t* H; int ldh;
    __device__ __forceinline__ void operator()(const f32x4 (&acc)[2][2][4][2], const Unit& u, int wr, int wc, int fr, int fq) const {
        const int row0 = u.pm * BM + wr * 64 + fr, col0 = u.pn * HALF + wc * 32 + 8 * fq;
#pragma unroll
        for (int ai = 0; ai < 2; ++ai)
#pragma unroll
            for (int m = 0; m < 4; ++m) { bf16_t* rowp = H + (size_t)(row0 + ai * HALF + m * 16) * ldh + col0;
                const f32x4 g0 = acc[ai][0][m][0], g1 = acc[ai][0][m][1], u0 = acc[ai][1][m][0], u1 = acc[ai][1][m][1];
                u32x4 w; w.x = cvt_pk_bf16(silu_mul(g0[0], u0[0]), silu_mul(g0[1], u0[1])); w.y = cvt_pk_bf16(silu_mul(g0[2], u0[2]), silu_mul(g0[3], u0[3]));
                w.z = cvt_pk_bf16(silu_mul(g1[0], u1[0]), silu_mul(g1[1], u1[1])); w.w = cvt_pk_bf16(silu_mul(g1[2], u1[2]), silu_mul(g1[3], u1[3]));
                *(u32x4*)rowp = w; }
    }
};
struct EpiResF32 {
    static constexpr bool PERM = false, AFTER_DRAIN = false;
    const float* base; float* out; int ldc; float alpha;
    __device__ __forceinline__ void operator()(const f32x4 (&acc)[2][2][4][2], const Unit& u, int wr, int wc, int fr, int fq) const {
        const int row0 = u.pm * BM + wr * 64 + fr, col0 = u.pn * BM + wc * 32 + 4 * fq;
#pragma unroll
        for (int ai = 0; ai < 2; ++ai)
#pragma unroll
            for (int m = 0; m < 4; ++m) { const size_t off = (size_t)(row0 + ai * HALF + m * 16) * ldc + col0;
                f32x4 bs[2][2];
#pragma unroll
                for (int bj = 0; bj < 2; ++bj)
#pragma unroll
                    for (int n = 0; n < 2; ++n) bs[bj][n] = *(const f32x4*)(base + off + bj * HALF + n * 16);
#pragma unroll
                for (int bj = 0; bj < 2; ++bj)
#pragma unroll
                    for (int n = 0; n < 2; ++n) *(f32x4*)(out + off + bj * HALF + n * 16) = bs[bj][n] + acc[ai][bj][m][n] * alpha;
                asm volatile("" ::: "memory"); }
    }
};

__device__ __forceinline__ float clamp448(float x) { return __builtin_fminf(__builtin_fmaxf(x, -448.f), 448.f); }
__device__ __forceinline__ unsigned pk4_fp8(float a, float b, float c, float d) {
    unsigned r = 0u; r = __builtin_amdgcn_cvt_pk_fp8_f32(clamp448(a), clamp448(b), r, false); r = __builtin_amdgcn_cvt_pk_fp8_f32(clamp448(c), clamp448(d), r, true); return r; }
typedef unsigned u32x2 __attribute__((ext_vector_type(2)));
struct EpiSwiGLUF8 {
    static constexpr bool PERM = true, AFTER_DRAIN = false;
    unsigned char* H; int ldh; float inv, hs;
    __device__ __forceinline__ void operator()(const f32x4 (&acc)[2][2][4][2], const Unit& u, int wr, int wc, int fr, int fq) const {
        const int row0 = u.pm * BM + wr * 64 + fr, col0 = u.pn * HALF + wc * 32 + 8 * fq;
#pragma unroll
        for (int ai = 0; ai < 2; ++ai)
#pragma unroll
            for (int m = 0; m < 4; ++m) { unsigned char* rowp = H + (size_t)(row0 + ai * HALF + m * 16) * ldh + col0;
                const f32x4 g0 = acc[ai][0][m][0] * inv, g1 = acc[ai][0][m][1] * inv, u0 = acc[ai][1][m][0] * (inv * hs), u1 = acc[ai][1][m][1] * (inv * hs);
                u32x2 w; w.x = pk4_fp8(silu_mul(g0[0], u0[0]), silu_mul(g0[1], u0[1]), silu_mul(g0[2], u0[2]), silu_mul(g0[3], u0[3]));
                w.y = pk4_fp8(silu_mul(g1[0], u1[0]), silu_mul(g1[1], u1[1]), silu_mul(g1[2], u1[2]), silu_mul(g1[3], u1[3]));
                *(u32x2*)rowp = w; }
    }
};

struct EpiProj {
    static constexpr bool PERM = true, AFTER_DRAIN = false;
    bf16_t* O; int ldc; const float* bias; float* ksum; int kcol0;
    __device__ __forceinline__ void operator()(const f32x4 (&acc)[2][2][4][2], const Unit& u, int wr, int wc, int fr, int fq) const {
        const int row0 = u.pm * BM + wr * 64 + fr, col0 = u.pn * BM + wc * 32 + 8 * fq;
        f32x4 bv[2][2];
#pragma unroll
        for (int bj = 0; bj < 2; ++bj)
#pragma unroll
            for (int n = 0; n < 2; ++n) bv[bj][n] = *(const f32x4*)(bias + col0 + bj * HALF + 4 * n);
#pragma unroll
        for (int ai = 0; ai < 2; ++ai)
#pragma unroll
            for (int m = 0; m < 4; ++m) { bf16_t* rowp = O + (size_t)(row0 + ai * HALF + m * 16) * ldc + col0;
#pragma unroll
                for (int bj = 0; bj < 2; ++bj) { const f32x4 v0 = acc[ai][bj][m][0] + bv[bj][0], v1 = acc[ai][bj][m][1] + bv[bj][1];
                    u32x4 w; w.x = cvt_pk_bf16(v0[0], v0[1]); w.y = cvt_pk_bf16(v0[2], v0[3]); w.z = cvt_pk_bf16(v1[0], v1[1]); w.w = cvt_pk_bf16(v1[2], v1[3]);
                    *(u32x4*)(rowp + bj * HALF) = w; } }
        const int kc = u.pn * BM - kcol0;
        if (kc >= 0 && kc < 2048) {
#pragma unroll
            for (int bj = 0; bj < 2; ++bj)
#pragma unroll
                for (int n = 0; n < 2; ++n) { f32x4 s = bv[bj][n] * 8.0f;
#pragma unroll
                    for (int ai = 0; ai < 2; ++ai)
#pragma unroll
                        for (int m = 0; m < 4; ++m) s = s + acc[ai][bj][m][n];
#pragma unroll
                    for (int jj = 0; jj < 4; ++jj) { float v = s[jj]; v += __shfl_xor(v, 1); v += __shfl_xor(v, 2); v += __shfl_xor(v, 4); v += __shfl_xor(v, 8); s[jj] = v; }
                    if (fr == 0) { const int c = kc + bj * HALF + wc * 32 + 8 * fq + 4 * n;
                        float* dst = ksum + ((size_t)u.pm * 16 + (c >> 7)) * 128 + (c & 127);
#pragma unroll
                        for (int jj = 0; jj < 4; ++jj) atomicAdd(dst + jj, s[jj]); } }
        }
    }
};
typedef int v4i_t __attribute__((ext_vector_type(4))); typedef int v8i_t __attribute__((ext_vector_type(8)));
__device__ __forceinline__ v8i_t cat8(bf16x8 a, bf16x8 b) { return __builtin_shufflevector(__builtin_bit_cast(v4i_t, a), __builtin_bit_cast(v4i_t, b), 0, 1, 2, 3, 4, 5, 6, 7); }
__device__ __forceinline__ void mfma_f8(f32x4& acc, v8i_t a, v8i_t b, int one) { asm volatile("v_mfma_scale_f32_16x16x128_f8f6f4 %0, %1, %2, %0, %3, %3 op_sel_hi:[0,0,0]" : "+v"(acc) : "v"(a), "v"(b), "v"(one)); }
template <class Epi, class Sched, bool ALIGN_EPI = false, bool SP2 = false, bool F8 = false>
__device__ __forceinline__ void gemm_phase(PG8_LAS unsigned char* lds, const Gemm g, const Sched& S, const Epi& E) {
    const int tid = threadIdx.x, wid = __builtin_amdgcn_readfirstlane(tid >> 6), lane = tid & 63, wr = wid >> 2, wc = wid & 3, fr = lane & 15, fq = lane >> 4;
    const int K = g.K, KB = F8 ? K : 2 * K  , nt = KB / (BK * 2);
    unsigned voffA[2], voffB[2];
#pragma unroll
    for (int i = 0; i < 2; ++i) { int R, C; stage_rc(tid * 16 + i * 8192, R, C); const int Rb = Epi::PERM ? ((R & ~31) + perm32(R & 31)) : R;
        voffA[i] = (unsigned)(R * KB + C * 2); voffB[i] = (unsigned)(Rb * KB + C * 2); }
    const size_t kstep = (size_t)(BK * 2);
    const size_t hstep = (size_t)HALF * KB;
    const size_t tstep = 2 * hstep;
    const unsigned ldsw = (unsigned)wid * 1024u;
    const int aoff = lds_byte(wr * 64 + fr, fq * 8), boff = lds_byte(wc * 32 + fr, fq * 8);
#define PG8_SA(b, h) (((b) * 2 + (h)) * HTB)
#define PG8_SB(b, h) ((4 + (b) * 2 + (h)) * HTB)
#define PG8_STAGE(bufoff, gbase, voff) do { _Pragma("unroll") for (int _i = 0; _i < 2; ++_i) \
        __builtin_amdgcn_global_load_lds((const unsigned*)((const char*)(gbase) + (voff)[_i]), (PG8_LAS unsigned*)(lds + (bufoff) + ldsw + _i * 8192), 16, 0, 0); } while (0)
#define PG8_LDA(dst, b, h) do { _Pragma("unroll") for (int m = 0; m < 4; ++m) _Pragma("unroll") for (int k = 0; k < 2; ++k) dst[m][k] = *(const PG8_LAS bf16x8*)(lds + PG8_SA(b, h) + aoff + m * 2048 + k * 1024); } while (0)
#define PG8_LDB(dst, b, h) do { _Pragma("unroll") for (int n = 0; n < 2; ++n) _Pragma("unroll") for (int k = 0; k < 2; ++k) dst[n][k] = *(const PG8_LAS bf16x8*)(lds + PG8_SB(b, h) + boff + n * 2048 + k * 1024); } while (0)
#define PG8_MMA(ai, bj, At, Bt) do { __builtin_amdgcn_s_setprio(1); _Pragma("unroll") for (int m = 0; m < 4; ++m) _Pragma("unroll") for (int n = 0; n < 2; ++n) { \
        if constexpr (F8) mfma_f8(acc[ai][bj][m][n], cat8(Bt[n][0], Bt[n][1]), cat8(At[m][0], At[m][1]), f8_one); \
        else { _Pragma("unroll") for (int k = 0; k < 2; ++k) acc[ai][bj][m][n] = __builtin_amdgcn_mfma_f32_16x16x32_bf16(Bt[n][k], At[m][k], acc[ai][bj][m][n], 0, 0, 0); } } \
        __builtin_amdgcn_s_setprio(0); } while (0)
#define PG8_WAIT_V(n) asm volatile("s_waitcnt vmcnt(" #n ")" ::: "memory")
#define PG8_WAIT_L(n) asm volatile("s_waitcnt lgkmcnt(" #n ")" ::: "memory")
#define PG8_BAR __builtin_amdgcn_s_barrier()
#define PG8_SCHED __builtin_amdgcn_sched_barrier(0)
    Unit cur, nxt; int ui = 0;
    int f8_one = 0x7f7f7f7f; if constexpr (F8) asm volatile("" : "+v"(f8_one));
    if (!S.next(0, cur)) return;
    f32x4 acc[2][2][4][2];
#pragma unroll
    for (int a = 0; a < 2; ++a)
#pragma unroll
        for (int b = 0; b < 2; ++b)
#pragma unroll
            for (int m = 0; m < 4; ++m)
#pragma unroll
                for (int n = 0; n < 2; ++n) acc[a][b][m][n] = (f32x4){0.f, 0.f, 0.f, 0.f};
    bf16x8 At[4][2], B0[2][2], B1[2][2];
    const char* cA = (const char*)g.A + (size_t)cur.pm * tstep; const char* cB = (const char*)g.Bt + (size_t)cur.pn * tstep;
    S.a_ready(cur);
    if constexpr (SP2) {
        PG8_STAGE(PG8_SB(0, 0), cB, voffB); PG8_STAGE(PG8_SB(0, 1), cB + hstep, voffB); PG8_STAGE(PG8_SA(0, 0), cA, voffA); PG8_STAGE(PG8_SA(0, 1), cA + hstep, voffA);
        if (wr == 1) PG8_BAR;
        PG8_WAIT_V(2); PG8_BAR;
        PG8_STAGE(PG8_SB(1, 0), cB + kstep, voffB); PG8_STAGE(PG8_SA(1, 0), cA + kstep, voffA); PG8_STAGE(PG8_SB(1, 1), cB + hstep + kstep, voffB);
        PG8_WAIT_V(6); PG8_BAR;
    } else {
        PG8_STAGE(PG8_SB(0, 0), cB, voffB); PG8_STAGE(PG8_SA(0, 0), cA, voffA); PG8_STAGE(PG8_SB(0, 1), cB + hstep, voffB); PG8_STAGE(PG8_SA(0, 1), cA + hstep, voffA);
        if (wr == 1) PG8_BAR;
        PG8_WAIT_V(4); PG8_BAR;
        PG8_STAGE(PG8_SB(1, 0), cB + kstep, voffB); PG8_STAGE(PG8_SA(1, 0), cA + kstep, voffA); PG8_STAGE(PG8_SB(1, 1), cB + hstep + kstep, voffB);
        PG8_WAIT_V(6); PG8_BAR;
    }
    for (;;) {
        const bool has_next = S.next(ui + 1, nxt);
        const char* nA = has_next ? (const char*)g.A + (size_t)nxt.pm * tstep : cA; const char* nB = has_next ? (const char*)g.Bt + (size_t)nxt.pn * tstep : cB;
        for (int t = 0; t < nt; t += 2) {
            const bool last = (t == nt - 2);
            const char* a1 = cA + (size_t)(t + 1) * kstep;
            const char* a2 = last ? nA : cA + (size_t)(t + 2) * kstep; const char* b2 = last ? nB : cB + (size_t)(t + 2) * kstep;
            const char* a3 = a2 + kstep; const char* b3 = b2 + kstep;
            if (last && has_next) S.a_ready(nxt);
            if constexpr (SP2) {
            PG8_LDB(B0, 0, 0); PG8_LDB(B1, 0, 1); PG8_SCHED; PG8_LDA(At, 0, 0); PG8_STAGE(PG8_SA(1, 1), a1 + hstep, voffA);
            PG8_WAIT_V(8); PG8_WAIT_L(0); PG8_BAR; PG8_MMA(0, 0, At, B0); PG8_MMA(0, 1, At, B1); PG8_BAR; PG8_SCHED;
            PG8_LDA(At, 0, 1); PG8_STAGE(PG8_SB(0, 0), b2, voffB); PG8_STAGE(PG8_SB(0, 1), b2 + hstep, voffB); PG8_STAGE(PG8_SA(0, 0), a2, voffA);
            PG8_WAIT_V(8); PG8_WAIT_L(0); PG8_BAR; PG8_MMA(1, 0, At, B0); PG8_MMA(1, 1, At, B1); PG8_BAR; PG8_SCHED;
            PG8_LDB(B0, 1, 0); PG8_LDB(B1, 1, 1); PG8_SCHED; PG8_LDA(At, 1, 0); PG8_STAGE(PG8_SA(0, 1), a2 + hstep, voffA);
            PG8_WAIT_V(8); PG8_WAIT_L(0); PG8_BAR; PG8_MMA(0, 0, At, B0); PG8_MMA(0, 1, At, B1); PG8_BAR; PG8_SCHED;
            PG8_LDA(At, 1, 1); PG8_STAGE(PG8_SB(1, 0), b3, voffB); PG8_STAGE(PG8_SB(1, 1), b3 + hstep, voffB); PG8_STAGE(PG8_SA(1, 0), a3, voffA);
            PG8_WAIT_V(8); PG8_WAIT_L(0); PG8_BAR; PG8_MMA(1, 0, At, B0); PG8_MMA(1, 1, At, B1); PG8_BAR; PG8_SCHED;
            } else {
            PG8_LDB(B0, 0, 0); PG8_SCHED; PG8_LDA(At, 0, 0); PG8_STAGE(PG8_SA(1, 1), a1 + hstep, voffA);
            PG8_WAIT_L(8); PG8_BAR; PG8_WAIT_L(0); PG8_MMA(0, 0, At, B0); PG8_BAR; PG8_SCHED;
            PG8_LDB(B1, 0, 1); PG8_STAGE(PG8_SB(0, 0), b2, voffB);
            PG8_BAR; PG8_WAIT_L(0); PG8_MMA(0, 1, At, B1); PG8_BAR;
            PG8_LDA(At, 0, 1); PG8_STAGE(PG8_SA(0, 0), a2, voffA);
            PG8_BAR; PG8_WAIT_L(0); PG8_MMA(1, 0, At, B0); PG8_BAR; PG8_SCHED;
            PG8_STAGE(PG8_SB(0, 1), b2 + hstep, voffB);
            PG8_WAIT_V(6); PG8_BAR; PG8_MMA(1, 1, At, B1); PG8_BAR;
            PG8_LDB(B0, 1, 0); PG8_SCHED; PG8_LDA(At, 1, 0); PG8_STAGE(PG8_SA(0, 1), a2 + hstep, voffA);
            PG8_WAIT_L(8); PG8_BAR; PG8_WAIT_L(0); PG8_MMA(0, 0, At, B0); PG8_BAR; PG8_SCHED;
            PG8_LDB(B1, 1, 1); PG8_STAGE(PG8_SB(1, 0), b3, voffB);
            PG8_BAR; PG8_WAIT_L(0); PG8_MMA(0, 1, At, B1); PG8_BAR;
            PG8_LDA(At, 1, 1); PG8_STAGE(PG8_SA(1, 0), a3, voffA);
            PG8_BAR; PG8_WAIT_L(0); PG8_MMA(1, 0, At, B0); PG8_BAR; PG8_SCHED;
            PG8_STAGE(PG8_SB(1, 1), b3 + hstep, voffB);
            PG8_WAIT_V(6); PG8_BAR; PG8_MMA(1, 1, At, B1); PG8_BAR;
            }
        }
        if constexpr (ALIGN_EPI) { if (wr == 0) PG8_BAR; }
        if constexpr (!Epi::AFTER_DRAIN) { E(acc, cur, wr, wc, fr, fq); S.done(cur); }
        if (!has_next) break;
#pragma unroll
        for (int a = 0; a < 2; ++a)
#pragma unroll
            for (int b = 0; b < 2; ++b)
#pragma unroll
                for (int m = 0; m < 4; ++m)
#pragma unroll
                    for (int n = 0; n < 2; ++n) acc[a][b][m][n] = (f32x4){0.f, 0.f, 0.f, 0.f};
        cur = nxt; cA = nA; cB = nB; ++ui;
        if constexpr (ALIGN_EPI) { if (wr == 1) PG8_BAR; }
    }
    PG8_WAIT_V(0);
    if constexpr (!ALIGN_EPI) { if (wr == 0) PG8_BAR; }
    PG8_BAR;
    if constexpr (Epi::AFTER_DRAIN) { E.fused(acc, cur, wr, wc, fr, fq, lds, wid, lane); S.done(cur); }
#undef PG8_SA
#undef PG8_SB
#undef PG8_STAGE
#undef PG8_LDA
#undef PG8_LDB
#undef PG8_MMA
#undef PG8_WAIT_V
#undef PG8_WAIT_L
#undef PG8_BAR
#undef PG8_SCHED
}
}

constexpr int NB = 4, SEQ = 4096, DM = 4096, FF = 11008, M = NB * SEQ;
constexpr int HD = 128, NHM = 16, NHS = 16, NKVS = 4, NMEM = 256, NHC = 4;
constexpr int MOBA_W = 2048, SWA_W = 2048, SWA_KV_W = 512, CROSS_W = 512, IN_W = 9216;
constexpr int COL_QM = 0, COL_KM = 2048, COL_VM = 4096, COL_QS = 6144, COL_KS = 8192, COL_VS = 8704;
constexpr float EPS = 1e-6f;
constexpr float LOG2E = 1.4426950408889634f;
constexpr float QK_C = 0.088388347648318440f * 1.4426950408889634f;
constexpr int NWAVES = 8;

constexpr size_t MiB = 1u << 20;
constexpr size_t WS_CTL = 0, CTL_ZERO_BYTES = 2 * MiB;
constexpr size_t WS_KMEAN = 1 * MiB;
constexpr size_t WS_KVC = 2 * MiB;
constexpr size_t WS_MEMN = 4 * MiB;
constexpr size_t WS_QC = 12 * MiB;
constexpr size_t WS_OC = 28 * MiB;
constexpr size_t WS_WCQ = 44 * MiB;
constexpr size_t WS_WCKV = 48 * MiB;
constexpr size_t WS_WCO = 56 * MiB;
constexpr size_t WS_WOUT = 60 * MiB;
constexpr size_t WS_WIN = 92 * MiB;
constexpr size_t WS_WGU1 = 164 * MiB;
constexpr size_t WS_WD1 = 336 * MiB;
constexpr size_t WS_WGU2 = 422 * MiB;
constexpr size_t WS_WD2 = 594 * MiB;
constexpr size_t WS_N = 680 * MiB;
constexpr size_t WS_H = 808 * MiB;
constexpr size_t WS_N8 = 1152 * MiB;
constexpr size_t WS_END = 1216 * MiB;
constexpr int CW_BAR = 4096;

constexpr int RING_OFF = 0, RING_BYTES = 131072;
constexpr int LDSCTL_OFF = RING_BYTES, MISC_OFF = LDSCTL_OFF + 320;
constexpr int LDS_BYTES = 147456;

#define GAS __attribute__((address_space(1)))
#define LAS __attribute__((address_space(3)))
typedef unsigned short bf16;
typedef unsigned v4u __attribute__((ext_vector_type(4)));
typedef unsigned v2u __attribute__((ext_vector_type(2)));
typedef float f32x4 __attribute__((ext_vector_type(4)));
typedef short bf16x8 __attribute__((ext_vector_type(8)));
typedef short s16x4 __attribute__((ext_vector_type(4)));
typedef GAS unsigned gu32;
#define RLX_AGENT __ATOMIC_RELAXED, __HIP_MEMORY_SCOPE_AGENT
#define LDS_WAIT() asm volatile("s_waitcnt lgkmcnt(0)" ::: "memory")
#define VM_WAIT() asm volatile("s_waitcnt vmcnt(0)" ::: "memory")
__device__ __forceinline__ unsigned f2bf(float f) { unsigned u = __builtin_bit_cast(unsigned, f); return (u + 0x7fffu + ((u >> 16) & 1u)) >> 16; }
__device__ __forceinline__ unsigned pk2(float lo, float hi) { return f2bf(lo) | (f2bf(hi) << 16); }
__device__ __forceinline__ float bf_lo(unsigned w) { return __builtin_bit_cast(float, w << 16); }
__device__ __forceinline__ float bf_hi(unsigned w) { return __builtin_bit_cast(float, w & 0xffff0000u); }
#define XB_TMO      128
#define XB_XCNT(j)  (256  + 64 * (j))
#define XB_XSUB(j)  (1280 + 64 * (j))
#define XB_XGEN(j)  (2304 + 64 * (j))
#define XB_TOP      3328
#define XB_TOPGEN   3392
#define XCD_BAR_WORDS 3456
#define XB_SPIN_CAP (1u << 18)

__device__ __forceinline__ unsigned xb_ld(unsigned* p)              { return __hip_atomic_load(p, __ATOMIC_RELAXED, __HIP_MEMORY_SCOPE_AGENT); }
__device__ __forceinline__ unsigned xb_add(unsigned* p, unsigned v) { return __hip_atomic_fetch_add(p, v, __ATOMIC_RELAXED, __HIP_MEMORY_SCOPE_AGENT); }
__device__ __forceinline__ unsigned xb_xcc_id() { return (unsigned)__builtin_amdgcn_s_getreg((3 << 11) | 20) & 0xFu; }
#define XB_SPIN(cond, bar) do { unsigned _sp = 0; while (cond) { __builtin_amdgcn_s_sleep(1); \
    if ((++_sp & 255u) == 0u) { if (xb_ld(&(bar)[XB_TMO])) break; if (_sp > XB_SPIN_CAP) { atomicAdd(&(bar)[XB_TMO], 1u); break; } } } } while (0)

struct XcdBarrier {
    unsigned* bar; unsigned x;
    volatile LAS unsigned* st;
};

__device__ __forceinline__ XcdBarrier xcd_barrier_post(unsigned* bar, volatile LAS unsigned* st) {
    XcdBarrier b; b.bar = bar; b.x = xb_xcc_id(); b.st = st;
    if (threadIdx.x == 0) (void)xb_add(&bar[XB_XCNT(b.x)], 1u);
    return b;
}
__device__ __forceinline__ void xcd_barrier_complete(unsigned* bar, unsigned x, unsigned& nloc, unsigned& nx) {
    const unsigned G = gridDim.x * gridDim.y * gridDim.z;
    unsigned sum, cnt, mine, sp = 0u;
    for (;;) {
        sum = 0u; cnt = 0u; mine = 0u;
#pragma unroll
        for (unsigned j = 0; j < 16; ++j) { const unsigned c = xb_ld(&bar[XB_XCNT(j)]); sum += c; cnt += (c > 0u) ? 1u : 0u; mine = (j == x) ? c : mine; }
        if (sum == G) break;
        __builtin_amdgcn_s_sleep(1);
        if ((++sp & 255u) == 0u) { if (xb_ld(&bar[XB_TMO])) break; if (sp > XB_SPIN_CAP) { atomicAdd(&bar[XB_TMO], 1u); break; } }
    }
    nloc = mine > 0u ? mine : 1u; nx = cnt > 0u ? cnt : 1u;
}

__device__ __forceinline__ void xcd_barrier(const XcdBarrier& b) {
    asm volatile("s_waitcnt vmcnt(0)" ::: "memory");
    __syncthreads();
    if (threadIdx.x == 0) {
        unsigned* bar = b.bar;
        __builtin_amdgcn_s_waitcnt(0);
        unsigned nloc = b.st[0], nx = b.st[1];
        if (nloc == 0u) { xcd_barrier_complete(bar, b.x, nloc, nx); b.st[0] = nloc; b.st[1] = nx; }
        const unsigned old = xb_add(&bar[XB_XSUB(b.x)], 1u);
        const unsigned gen = old / nloc;
        if (old + 1u == (gen + 1u) * nloc) {
            __builtin_amdgcn_fence(__ATOMIC_RELEASE, "agent");
            asm volatile("s_waitcnt vmcnt(0)" ::: "memory");
            const unsigned og = xb_add(&bar[XB_TOP], 1u);
            const unsigned tg = og / nx;
            if (og + 1u == (tg + 1u) * nx) xb_add(&bar[XB_TOPGEN], 1u);
            else XB_SPIN(xb_ld(&bar[XB_TOPGEN]) == tg, bar);
            __builtin_amdgcn_fence(__ATOMIC_ACQUIRE, "agent");
            xb_add(&bar[XB_XGEN(b.x)], 1u);
            asm volatile("s_waitcnt vmcnt(0)" ::: "memory");
        } else {
            XB_SPIN(xb_ld(&bar[XB_XGEN(b.x)]) == gen, bar);
            __builtin_amdgcn_fence(__ATOMIC_ACQUIRE, "agent");
            asm volatile("s_waitcnt vmcnt(0)" ::: "memory");
        }
    }
    __syncthreads();
}

__device__ __forceinline__ float wave_sum(float v) {
#pragma unroll
    for (int o = 1; o < 64; o <<= 1) v += __shfl_xor(v, o);
    return v;
}
__device__ __forceinline__ void cvt_item(const float* W, int K, int N, bf16* WT, int grp, int gstride, int goff, LAS float* scr, int item, int lane) {
    const int nblk = N / 32, kb = item / nblk, nb = item % nblk, k0 = 64 * kb, n0 = 32 * nb;
    const int orow0 = (n0 / grp) * gstride + goff + (n0 % grp);
#pragma unroll 4
    for (int i = 0; i < 32; ++i) { const int kk = 2 * i + (lane >> 5); scr[kk * 33 + (lane & 31)] = W[(size_t)(k0 + kk) * N + n0 + (lane & 31)]; }
    LDS_WAIT(); asm volatile("" ::: "memory");
    const int c = lane & 7;
#pragma unroll
    for (int j = 0; j < 4; ++j) { const int n = (lane >> 3) + 8 * j; const LAS float* s = scr + (8 * c) * 33 + n;
        v4u o; o.x = pk2(s[0 * 33], s[1 * 33]); o.y = pk2(s[2 * 33], s[3 * 33]); o.z = pk2(s[4 * 33], s[5 * 33]); o.w = pk2(s[6 * 33], s[7 * 33]);
        *(v4u*)(WT + (size_t)(orow0 + n) * K + k0 + 8 * c) = o; }
    LDS_WAIT(); asm volatile("" ::: "memory");
}
__device__ __forceinline__ void rms_row_bf16(const float* xrow, const float* g, bf16* orow, int lane) {
    const f32x4* xr = (const f32x4*)xrow + lane;
    f32x4 v[16]; float s = 0.f;
#pragma unroll
    for (int j = 0; j < 16; ++j) { v[j] = xr[64 * j]; s += (v[j].x * v[j].x + v[j].y * v[j].y) + (v[j].z * v[j].z + v[j].w * v[j].w); }
    const float rstd = 1.0f / sqrtf(wave_sum(s) * (1.f / DM) + EPS);
    const f32x4* gr = (const f32x4*)g + lane;
    v2u* o8 = (v2u*)orow + lane;
#pragma unroll
    for (int j = 0; j < 16; ++j) { const f32x4 gg = gr[64 * j]; v2u w; w.x = pk2(v[j].x * rstd * gg.x, v[j].y * rstd * gg.y); w.y = pk2(v[j].z * rstd * gg.z, v[j].w * rstd * gg.w); o8[64 * j] = w; }
}
__device__ __forceinline__ void cvt_item_f8(const float* W, int K, int N, unsigned char* WT, int grp, int gstride, int goff, float scale, LAS float* scr, int item, int lane) {
    const int nblk = N / 32, kb = item / nblk, nb = item % nblk, k0 = 64 * kb, n0 = 32 * nb;
    const int orow0 = (n0 / grp) * gstride + goff + (n0 % grp);
#pragma unroll 4
    for (int i = 0; i < 32; ++i) { const int kk = 2 * i + (lane >> 5); scr[kk * 33 + (lane & 31)] = W[(size_t)(k0 + kk) * N + n0 + (lane & 31)]; }
    LDS_WAIT(); asm volatile("" ::: "memory");
    const int c = lane & 3;
#pragma unroll
    for (int j = 0; j < 2; ++j) { const int n = (lane >> 2) + 16 * j; const LAS float* s = scr + (16 * c) * 33 + n;
        v4u o;
        o.x = pg8::pk4_fp8(s[0 * 33] * scale, s[1 * 33] * scale, s[2 * 33] * scale, s[3 * 33] * scale); o.y = pg8::pk4_fp8(s[4 * 33] * scale, s[5 * 33] * scale, s[6 * 33] * scale, s[7 * 33] * scale);
        o.z = pg8::pk4_fp8(s[8 * 33] * scale, s[9 * 33] * scale, s[10 * 33] * scale, s[11 * 33] * scale); o.w = pg8::pk4_fp8(s[12 * 33] * scale, s[13 * 33] * scale, s[14 * 33] * scale, s[15 * 33] * scale);
        *(v4u*)(WT + (size_t)(orow0 + n) * K + k0 + 16 * c) = o; }
    LDS_WAIT(); asm volatile("" ::: "memory");
}
__device__ __forceinline__ void rms_row_bf16_f8(const float* xrow, const float* g, bf16* orow, unsigned char* orow8, int lane) {
    const f32x4* xr = (const f32x4*)xrow + lane;
    f32x4 v[16]; float s = 0.f;
#pragma unroll
    for (int j = 0; j < 16; ++j) { v[j] = xr[64 * j]; s += (v[j].x * v[j].x + v[j].y * v[j].y) + (v[j].z * v[j].z + v[j].w * v[j].w); }
    const float rstd = 1.0f / sqrtf(wave_sum(s) * (1.f / DM) + EPS);
    const f32x4* gr = (const f32x4*)g + lane;
    v2u* o8 = (v2u*)orow + lane; unsigned* o4 = (unsigned*)orow8 + lane;
#pragma unroll
    for (int j = 0; j < 16; ++j) { const f32x4 gg = gr[64 * j]; const float a = v[j].x * rstd * gg.x, b = v[j].y * rstd * gg.y, c = v[j].z * rstd * gg.z, d = v[j].w * rstd * gg.w;
        v2u w; w.x = pk2(a, b); w.y = pk2(c, d); o8[64 * j] = w; o4[64 * j] = pg8::pk4_fp8(a, b, c, d); }
}
__device__ __forceinline__ void rms_row_f8(const float* xrow, const float* g, unsigned char* orow, int lane) {
    const f32x4* xr = (const f32x4*)xrow + lane;
    f32x4 v[16]; float s = 0.f;
#pragma unroll
    for (int j = 0; j < 16; ++j) { v[j] = xr[64 * j]; s += (v[j].x * v[j].x + v[j].y * v[j].y) + (v[j].z * v[j].z + v[j].w * v[j].w); }
    const float rstd = 1.0f / sqrtf(wave_sum(s) * (1.f / DM) + EPS);
    const f32x4* gr = (const f32x4*)g + lane;
    unsigned* o4 = (unsigned*)orow + lane;
#pragma unroll
    for (int j = 0; j < 16; ++j) { const f32x4 gg = gr[64 * j]; o4[64 * j] = pg8::pk4_fp8(v[j].x * rstd * gg.x, v[j].y * rstd * gg.y, v[j].z * rstd * gg.z, v[j].w * rstd * gg.w); }
}
__device__ __forceinline__ void rms_row_f32(float* xrow, const float* g, int lane) {
    f32x4* xr = (f32x4*)xrow + lane;
    f32x4 v[16]; float s = 0.f;
#pragma unroll
    for (int j = 0; j < 16; ++j) { v[j] = xr[64 * j]; s += (v[j].x * v[j].x + v[j].y * v[j].y) + (v[j].z * v[j].z + v[j].w * v[j].w); }
    const float rstd = 1.0f / sqrtf(wave_sum(s) * (1.f / DM) + EPS);
    const f32x4* gr = (const f32x4*)g + lane;
#pragma unroll
    for (int j = 0; j < 16; ++j) { const f32x4 gg = gr[64 * j]; xr[64 * j] = v[j] * rstd * gg; }
}
__device__ __forceinline__ void onorm_row_f8(const bf16* orow, unsigned char* orow8, const float* gm, const float* gs, int lane) {
    const int half = lane >> 5, l32 = lane & 31;
    const v4u* p = (const v4u*)(orow + half * 2048) + l32;
    v4u v[8]; float s = 0.f;
#pragma unroll
    for (int j = 0; j < 8; ++j) { v[j] = p[32 * j];
#pragma unroll
        for (int e = 0; e < 4; ++e) { const float a = bf_lo(v[j][e]), b = bf_hi(v[j][e]); s += a * a + b * b; } }
#pragma unroll
    for (int o = 1; o < 32; o <<= 1) s += __shfl_xor(s, o);
    const float rstd = 1.0f / sqrtf(s * (1.f / 2048.f) + EPS);
    const float* g = half ? gs : gm;
    asm volatile("s_waitcnt vmcnt(0)" ::: "memory");
    v2u* q = (v2u*)(orow8 + half * 2048) + l32;
#pragma unroll
    for (int j = 0; j < 8; ++j) { const f32x4* gp = (const f32x4*)(g + (l32 + 32 * j) * 8); const f32x4 g0 = gp[0], g1 = gp[1]; v2u w;
        w.x = pg8::pk4_fp8(bf_lo(v[j].x) * rstd * g0.x, bf_hi(v[j].x) * rstd * g0.y, bf_lo(v[j].y) * rstd * g0.z, bf_hi(v[j].y) * rstd * g0.w);
        w.y = pg8::pk4_fp8(bf_lo(v[j].z) * rstd * g1.x, bf_hi(v[j].z) * rstd * g1.y, bf_lo(v[j].w) * rstd * g1.z, bf_hi(v[j].w) * rstd * g1.w);
        q[32 * j] = w; }
}

namespace att {
constexpr int KST = 272, VST = 288;
constexpr int K_OFF = 0, V_OFF = 64 * KST, TILE_BYTES = V_OFF + 64 * VST  , KM_OFF = 2 * TILE_BYTES, LUT_OFF = KM_OFF + 16 * 128 * 4, LUT_STRIDE = 132  , RED_OFF = LUT_OFF + 2 * LUT_STRIDE * 4, END_OFF = RED_OFF + 8 * 128 * 4;
constexpr float SM_THR = 8.f;
static_assert(END_OFF <= RING_BYTES && V_OFF % 16 == 0 && KM_OFF % 16 == 0 && TILE_BYTES % 16 == 0, "attention LDS map");

__device__ __forceinline__ int t5_bucket(int n) {
    if (n < 16) return n;
    return 16 + (n >= 19) + (n >= 21) + (n >= 24) + (n >= 27) + (n >= 31) + (n >= 35) + (n >= 40) + (n >= 46) + (n >= 52) + (n >= 59) + (n >= 67) + (n >= 77) + (n >= 87) + (n >= 99) + (n >= 113);
}
__device__ __forceinline__ float bf2f(short s) { return __builtin_bit_cast(float, ((unsigned)(unsigned short)s) << 16); }

__device__ __forceinline__ void kv_load(const bf16* Kg, const bf16* Vg, int ld, int tid, v4u (&kr)[2], v4u (&vr)[2]) {
#pragma unroll
    for (int i = 0; i < 2; ++i) { const int c = tid + 512 * i, row = c >> 4, col = (c & 15) * 8;
        kr[i] = *(const v4u*)(Kg + (size_t)row * ld + col); vr[i] = *(const v4u*)(Vg + (size_t)row * ld + col); }
}
__device__ __forceinline__ void kv_store(LAS unsigned char* L, int tid, const v4u (&kr)[2], const v4u (&vr)[2]) {
#pragma unroll
    for (int i = 0; i < 2; ++i) { const int c = tid + 512 * i, row = c >> 4, cb = (c & 15) * 16;
        *(LAS v4u*)(L + K_OFF + row * KST + cb) = kr[i]; *(LAS v4u*)(L + V_OFF + row * VST + cb) = vr[i]; }
}
__device__ __forceinline__ void q_load(const bf16* Qp, int ldq, int row0, int j, int g, bf16x8 (&qf)[2][4]) {
#pragma unroll
    for (int qg = 0; qg < 2; ++qg)
#pragma unroll
        for (int dd = 0; dd < 4; ++dd) qf[qg][dd] = *(const bf16x8*)(Qp + (size_t)(row0 + 16 * qg + j) * ldq + 32 * dd + 8 * g);
}
__device__ __forceinline__ void qk_tile(LAS unsigned char* L, const bf16x8 (&qf)[2][4], f32x4 (&t)[2][4], int j, int g) {
    const LAS unsigned char* base = L + K_OFF + j * KST + g * 16;
    bf16x8 kf[2][4];
#pragma unroll
    for (int dd = 0; dd < 4; ++dd) kf[0][dd] = *(const LAS bf16x8*)(base + dd * 64);
#pragma unroll
    for (int ks = 0; ks < 4; ++ks) {
        if (ks + 1 < 4) {
#pragma unroll
            for (int dd = 0; dd < 4; ++dd) kf[(ks + 1) & 1][dd] = *(const LAS bf16x8*)(base + (ks + 1) * 16 * KST + dd * 64); }
        __builtin_amdgcn_sched_barrier(0);
        __builtin_amdgcn_s_setprio(2);
        t[0][ks] = (f32x4){0.f, 0.f, 0.f, 0.f}; t[1][ks] = (f32x4){0.f, 0.f, 0.f, 0.f};
#pragma unroll
        for (int dd = 0; dd < 4; ++dd) {
            t[0][ks] = __builtin_amdgcn_mfma_f32_16x16x32_bf16(kf[ks & 1][dd], qf[0][dd], t[0][ks], 0, 0, 0);
            t[1][ks] = __builtin_amdgcn_mfma_f32_16x16x32_bf16(kf[ks & 1][dd], qf[1][dd], t[1][ks], 0, 0, 0); }
        __builtin_amdgcn_s_setprio(0);
        __builtin_amdgcn_sched_barrier(0); }
}
__device__ __forceinline__ void pv_tile(LAS unsigned char* L, const bf16x8 (&pf)[2][2], f32x4 (&o)[2][8], int lane) {
    const int g = lane >> 4, q_ = (lane & 15) >> 2, p_ = lane & 3;
    LAS unsigned char* base = L + V_OFF + (4 * g + q_) * VST + p_ * 8;
    s16x4 lo[2][2], hi[2][2];
#define PV_LOAD(buf, grp) do { _Pragma("unroll") for (int e = 0; e < 2; ++e) { const int kk_ = (grp) >> 2, ds_ = 2 * ((grp) & 3) + e; \
        lo[buf][e] = __builtin_amdgcn_ds_read_tr16_b64_v4i16((LAS s16x4*)(base + (32 * kk_) * VST + ds_ * 32)); \
        hi[buf][e] = __builtin_amdgcn_ds_read_tr16_b64_v4i16((LAS s16x4*)(base + (32 * kk_ + 16) * VST + ds_ * 32)); } } while (0)
    PV_LOAD(0, 0);
#pragma unroll
    for (int grp = 0; grp < 8; ++grp) {
        if (grp + 1 < 8) PV_LOAD((grp + 1) & 1, grp + 1);
        __builtin_amdgcn_sched_barrier(0);
        __builtin_amdgcn_s_setprio(2);
#pragma unroll
        for (int e = 0; e < 2; ++e) { const int kk = grp >> 2, ds = 2 * (grp & 3) + e; const s16x4 a = lo[grp & 1][e], c = hi[grp & 1][e];
            const bf16x8 vf = (bf16x8){a[0], a[1], a[2], a[3], c[0], c[1], c[2], c[3]};
            o[0][ds] = __builtin_amdgcn_mfma_f32_16x16x32_bf16(vf, pf[0][kk], o[0][ds], 0, 0, 0);
            o[1][ds] = __builtin_amdgcn_mfma_f32_16x16x32_bf16(vf, pf[1][kk], o[1][ds], 0, 0, 0); }
        __builtin_amdgcn_s_setprio(0);
        __builtin_amdgcn_sched_barrier(0); }
#undef PV_LOAD
}
__device__ __forceinline__ void sm_update(f32x4 (&t)[2][4], float (&m)[2], float (&l)[2], f32x4 (&o)[2][8], bf16x8 (&pf)[2][2]) {
    float mx[2];
#pragma unroll
    for (int qg = 0; qg < 2; ++qg) { float v = -INFINITY;
#pragma unroll
        for (int ks = 0; ks < 4; ++ks)
#pragma unroll
            for (int r = 0; r < 4; ++r) v = fmaxf(v, t[qg][ks][r]);
        v = fmaxf(v, __shfl_xor(v, 16)); v = fmaxf(v, __shfl_xor(v, 32)); mx[qg] = v; }
    const bool grow = (mx[0] > m[0] + SM_THR) || (mx[1] > m[1] + SM_THR);
    if (__any((int)grow)) {
#pragma unroll
        for (int qg = 0; qg < 2; ++qg) { const float mn = fmaxf(m[qg], mx[qg]); const float mref = (mn == -INFINITY) ? 0.f : mn;
            const float alpha = __builtin_amdgcn_exp2f(m[qg] - mref); l[qg] *= alpha; m[qg] = mn;
#pragma unroll
            for (int ds = 0; ds < 8; ++ds) o[qg][ds] = o[qg][ds] * alpha; }
    }
#pragma unroll
    for (int qg = 0; qg < 2; ++qg) { const float mref = (m[qg] == -INFINITY) ? 0.f : m[qg]; float ps = 0.f;
#pragma unroll
        for (int ks = 0; ks < 4; ++ks)
#pragma unroll
            for (int r = 0; r < 4; ++r) { const float p = __builtin_amdgcn_exp2f(t[qg][ks][r] - mref); t[qg][ks][r] = p; ps += p; }
        l[qg] += ps;
#pragma unroll
        for (int kk = 0; kk < 2; ++kk) { v4u w;
            w.x = pg8::cvt_pk_bf16(t[qg][2 * kk][0], t[qg][2 * kk][1]); w.y = pg8::cvt_pk_bf16(t[qg][2 * kk][2], t[qg][2 * kk][3]);
            w.z = pg8::cvt_pk_bf16(t[qg][2 * kk + 1][0], t[qg][2 * kk + 1][1]); w.w = pg8::cvt_pk_bf16(t[qg][2 * kk + 1][2], t[qg][2 * kk + 1][3]);
            pf[qg][kk] = __builtin_bit_cast(bf16x8, w); }
    }
}
__device__ __forceinline__ void o_store(bf16* Op, int ldo, int row0, float (&l)[2], f32x4 (&o)[2][8], int j, int g) {
#pragma unroll
    for (int qg = 0; qg < 2; ++qg) { float lt = l[qg]; lt += __shfl_xor(lt, 16); lt += __shfl_xor(lt, 32); const float inv = 1.0f / lt;
        bf16* rp = Op + (size_t)(row0 + 16 * qg + j) * ldo + 4 * g;
#pragma unroll
        for (int ds = 0; ds < 8; ++ds) { const f32x4 v = o[qg][ds] * inv; v2u w; w.x = pk2(v.x, v.y); w.y = pk2(v.z, v.w); *(v2u*)(rp + 16 * ds) = w; } }
}

__device__ __forceinline__ void moba_unit(LAS unsigned char* L, const bf16* proj, const float* kmean, const float* rel_bias, bf16* Ob, int b, int h, int qb, int tid_) {
    int tid = tid_; asm volatile("" : "+v"(tid));
    const int lane = tid & 63, wave = __builtin_amdgcn_readfirstlane(tid >> 6), j = lane & 15, g = lane >> 4;
    const bf16* Qp = proj + (size_t)(b * SEQ + 256 * qb) * IN_W + COL_QM + h * HD;
    const bf16* Kp = proj + (size_t)(b * SEQ) * IN_W + COL_KM + h * HD;
    const bf16* Vp = proj + (size_t)(b * SEQ) * IN_W + COL_VM + h * HD;
    bf16* Op = Ob + (size_t)(b * SEQ + 256 * qb) * DM + h * HD;
    const int ntiles = 4 + 4 * qb;
    __syncthreads();
    { const int idx = tid * 4, n = idx >> 7; f32x4 v = (f32x4){0.f, 0.f, 0.f, 0.f};
      if (n < qb) v = *(const f32x4*)(kmean + (size_t)((b * 16 + n) * 16 + h) * 128 + (idx & 127)) * (1.0f / 256.0f);
      *(LAS f32x4*)(L + KM_OFF + idx * 4) = v; }
    if (tid < 128) *(LAS float*)(L + LUT_OFF + tid * 4) = rel_bias[t5_bucket(tid) * 32 + h] * LOG2E;
    if (tid == 128) *(LAS float*)(L + LUT_OFF + 128 * 4) = -INFINITY;
    v4u kr[2], vr[2];
    kv_load(Kp + (size_t)(256 * qb) * IN_W, Vp + (size_t)(256 * qb) * IN_W, IN_W, tid, kr, vr);
    bf16x8 qf[2][4];
    q_load(Qp, IN_W, 32 * wave, j, g, qf);
    kv_store(L, tid, kr, vr);
    kv_load(Kp + (size_t)(256 * qb + 64) * IN_W, Vp + (size_t)(256 * qb + 64) * IN_W, IN_W, tid, kr, vr);
    __syncthreads();
    unsigned sel[2];
    {
        float v1[2] = {-INFINITY, -INFINITY}, v2[2] = {-INFINITY, -INFINITY}, v3[2] = {-INFINITY, -INFINITY}; int i1[2] = {-1, -1}, i2[2] = {-1, -1}, i3[2] = {-1, -1};
#pragma unroll 1
        for (int n = 0; n < qb; ++n) {
            float a[2] = {0.f, 0.f};
#pragma unroll
            for (int dd = 0; dd < 4; ++dd) { const LAS f32x4* kp = (const LAS f32x4*)(L + KM_OFF + (n * 128 + 32 * dd + 8 * g) * 4); const f32x4 ka = kp[0], kb = kp[1];
#pragma unroll
                for (int qg = 0; qg < 2; ++qg) { a[qg] += bf2f(qf[qg][dd][0]) * ka.x; a[qg] += bf2f(qf[qg][dd][1]) * ka.y; a[qg] += bf2f(qf[qg][dd][2]) * ka.z; a[qg] += bf2f(qf[qg][dd][3]) * ka.w;
                    a[qg] += bf2f(qf[qg][dd][4]) * kb.x; a[qg] += bf2f(qf[qg][dd][5]) * kb.y; a[qg] += bf2f(qf[qg][dd][6]) * kb.z; a[qg] += bf2f(qf[qg][dd][7]) * kb.w; } }
#pragma unroll
            for (int qg = 0; qg < 2; ++qg) { float v = a[qg]; v += __shfl_xor(v, 16); v += __shfl_xor(v, 32);
                const bool c1 = v > v1[qg], c2 = v > v2[qg], c3 = v > v3[qg];
                v3[qg] = c2 ? v2[qg] : (c3 ? v : v3[qg]); i3[qg] = c2 ? i2[qg] : (c3 ? n : i3[qg]);
                v2[qg] = c1 ? v1[qg] : (c2 ? v : v2[qg]); i2[qg] = c1 ? i1[qg] : (c2 ? n : i2[qg]);
                v1[qg] = c1 ? v : v1[qg];                 i1[qg] = c1 ? n : i1[qg]; }
        }
#pragma unroll
        for (int qg = 0; qg < 2; ++qg) sel[qg] = (i1[qg] >= 0 ? (1u << i1[qg]) : 0u) | (i2[qg] >= 0 ? (1u << i2[qg]) : 0u) | (i3[qg] >= 0 ? (1u << i3[qg]) : 0u);
    }
    float m[2] = {-INFINITY, -INFINITY}, l[2] = {0.f, 0.f}; f32x4 o[2][8];
#pragma unroll
    for (int qg = 0; qg < 2; ++qg)
#pragma unroll
        for (int ds = 0; ds < 8; ++ds) o[qg][ds] = (f32x4){0.f, 0.f, 0.f, 0.f};
    const LAS float* lut = (const LAS float*)(L + LUT_OFF);
    const float lutfar = lut[127];
#pragma unroll 1
    for (int it = 0; it < ntiles; ++it) {
        LAS unsigned char* Lb = L + (it & 1) * TILE_BYTES;
        if (it + 1 < ntiles) kv_store(L + ((it + 1) & 1) * TILE_BYTES, tid, kr, vr);
        const bool own = it < 4; const int n = own ? qb : ((it - 4) >> 2), kt = own ? it : ((it - 4) & 3);
        if (it + 2 < ntiles) { const int it2 = it + 2; const bool own2 = it2 < 4; const int n2 = own2 ? qb : ((it2 - 4) >> 2), kt2 = own2 ? it2 : ((it2 - 4) & 3);
            const size_t kro = (size_t)(256 * n2 + 64 * kt2) * IN_W; kv_load(Kp + kro, Vp + kro, IN_W, tid, kr, vr); }
        bool active;
        if (own) active = (64 * kt <= 32 * wave + 31);
        else active = __any((int)(((sel[0] | sel[1]) >> n) & 1u)) != 0;
        if (active) {
            f32x4 t[2][4];
            qk_tile(Lb, qf, t, j, g);
            const int dbase = 256 * (qb - n) - 64 * kt + 32 * wave;
            if ((dbase - 63) < 127) {
#pragma unroll
                for (int qg = 0; qg < 2; ++qg) { const bool selq = own || (((sel[qg] >> n) & 1u) != 0u);
#pragma unroll
                    for (int ks = 0; ks < 4; ++ks)
#pragma unroll
                        for (int r = 0; r < 4; ++r) { const int d = dbase + (16 * qg + j) - (16 * ks + 4 * g + r);
                            const int dc = (selq && d >= 0) ? (d > 127 ? 127 : d) : 128;
                            t[qg][ks][r] = fmaf(t[qg][ks][r], QK_C, lut[dc]); } }
            } else {
#pragma unroll
                for (int qg = 0; qg < 2; ++qg) { const float bq = (own || (((sel[qg] >> n) & 1u) != 0u)) ? lutfar : -INFINITY;
#pragma unroll
                    for (int ks = 0; ks < 4; ++ks)
#pragma unroll
                        for (int r = 0; r < 4; ++r) t[qg][ks][r] = fmaf(t[qg][ks][r], QK_C, bq); }
            }
            bf16x8 pf[2][2];
            sm_update(t, m, l, o, pf);
            pv_tile(Lb, pf, o, lane);
        }
        __syncthreads();
    }
    o_store(Op, DM, 32 * wave, l, o, j, g);
}

__device__ __forceinline__ void swa_unit(LAS unsigned char* L, const bf16* proj, const float* rel_bias, const float* sinks, bf16* Ob, int b, int kvh, int i, int p, int tid_) {
    int tid = tid_; asm volatile("" : "+v"(tid));
    const int lane = tid & 63, wave = __builtin_amdgcn_readfirstlane(tid >> 6);
    const int j = lane & 15, g = lane >> 4, w4 = wave & 3, hq = 4 * kvh + 2 * p + (wave >> 2);
    const bf16* Qp = proj + (size_t)(b * SEQ + 128 * i) * IN_W + COL_QS + hq * HD;
    const bf16* Kp = proj + (size_t)(b * SEQ) * IN_W + COL_KS + kvh * HD;
    const bf16* Vp = proj + (size_t)(b * SEQ) * IN_W + COL_VS + kvh * HD;
    bf16* Op = Ob + (size_t)(b * SEQ + 128 * i) * DM + MOBA_W + hq * HD;
    const int kt0 = (i == 0) ? 2 : 0;
    __syncthreads();
    if (tid < 256) { const int hh = 4 * kvh + 2 * p + (tid >> 7), d = tid & 127; *(LAS float*)(L + LUT_OFF + ((tid >> 7) * LUT_STRIDE + d) * 4) = rel_bias[t5_bucket(d) * 32 + 16 + hh] * LOG2E; }
    if (tid >= 256 && tid < 258) *(LAS float*)(L + LUT_OFF + ((tid - 256) * LUT_STRIDE + 128) * 4) = -INFINITY;
    v4u kr[2], vr[2];
    { const long kro = (long)(128 * (i - 1) + 64 * kt0) * IN_W; kv_load(Kp + kro, Vp + kro, IN_W, tid, kr, vr); }
    bf16x8 qf[2][4];
    q_load(Qp, IN_W, 32 * w4, j, g, qf);
    kv_store(L + (kt0 & 1) * TILE_BYTES, tid, kr, vr);
    { const long kro = (long)(128 * (i - 1) + 64 * (kt0 + 1)) * IN_W; kv_load(Kp + kro, Vp + kro, IN_W, tid, kr, vr); }
    __syncthreads();
    const float sk = sinks[hq] * LOG2E;
    float m[2] = {sk, sk}, l[2] = {g == 0 ? 1.f : 0.f, g == 0 ? 1.f : 0.f}; f32x4 o[2][8];
#pragma unroll
    for (int qg = 0; qg < 2; ++qg)
#pragma unroll
        for (int ds = 0; ds < 8; ++ds) o[qg][ds] = (f32x4){0.f, 0.f, 0.f, 0.f};
    const LAS float* lut = (const LAS float*)(L + LUT_OFF) + LUT_STRIDE * (wave >> 2);
#pragma unroll 1
    for (int kt = kt0; kt < 4; ++kt) {
        LAS unsigned char* Lb = L + (kt & 1) * TILE_BYTES;
        if (kt + 1 < 4) kv_store(L + ((kt + 1) & 1) * TILE_BYTES, tid, kr, vr);
        if (kt + 2 < 4) { const long kro = (long)(128 * (i - 1) + 64 * (kt + 2)) * IN_W; kv_load(Kp + kro, Vp + kro, IN_W, tid, kr, vr); }
        const int dbase = 128 + 32 * w4 - 64 * kt;
        const bool active = (dbase + 31 >= 0) && (dbase - 63 <= 127);
        if (active) {
            f32x4 t[2][4];
            qk_tile(Lb, qf, t, j, g);
#pragma unroll
            for (int qg = 0; qg < 2; ++qg)
#pragma unroll
                for (int ks = 0; ks < 4; ++ks)
#pragma unroll
                    for (int r = 0; r < 4; ++r) { const int d = dbase + (16 * qg + j) - (16 * ks + 4 * g + r);
                        const int dc = ((unsigned)d < 128u) ? d : 128;
                        t[qg][ks][r] = fmaf(t[qg][ks][r], QK_C, lut[dc]); }
            bf16x8 pf[2][2];
            sm_update(t, m, l, o, pf);
            pv_tile(Lb, pf, o, lane);
        }
        __syncthreads();
    }
    o_store(Op, DM, 32 * w4, l, o, j, g);
}

__device__ __forceinline__ void cross_unit(LAS unsigned char* L, const bf16* qc, const bf16* kvc, bf16* oc, int b, int hc, int qt, int tid_) {
    int tid = tid_; asm volatile("" : "+v"(tid));
    const int lane = tid & 63, wave = __builtin_amdgcn_readfirstlane(tid >> 6), j = lane & 15, g = lane >> 4;
    const bf16* Qp = qc + (size_t)(b * SEQ + 256 * qt) * CROSS_W + hc * HD;
    const bf16* Kp = kvc + (size_t)(b * NMEM) * 1024 + hc * HD;
    const bf16* Vp = Kp + 512;
    bf16* Op = oc + (size_t)(b * SEQ + 256 * qt) * CROSS_W + hc * HD;
    __syncthreads();
    v4u kr[2], vr[2];
    kv_load(Kp, Vp, 1024, tid, kr, vr);
    bf16x8 qf[2][4];
    q_load(Qp, CROSS_W, 32 * wave, j, g, qf);
    kv_store(L, tid, kr, vr);
    kv_load(Kp + (size_t)64 * 1024, Vp + (size_t)64 * 1024, 1024, tid, kr, vr);
    __syncthreads();
    float m[2] = {-INFINITY, -INFINITY}, l[2] = {0.f, 0.f}; f32x4 o[2][8];
#pragma unroll
    for (int qg = 0; qg < 2; ++qg)
#pragma unroll
        for (int ds = 0; ds < 8; ++ds) o[qg][ds] = (f32x4){0.f, 0.f, 0.f, 0.f};
#pragma unroll 1
    for (int kt = 0; kt < 4; ++kt) {
        LAS unsigned char* Lb = L + (kt & 1) * TILE_BYTES;
        if (kt + 1 < 4) kv_store(L + ((kt + 1) & 1) * TILE_BYTES, tid, kr, vr);
        if (kt + 2 < 4) { const size_t kro = (size_t)(64 * (kt + 2)) * 1024; kv_load(Kp + kro, Vp + kro, 1024, tid, kr, vr); }
        f32x4 t[2][4];
        qk_tile(Lb, qf, t, j, g);
#pragma unroll
        for (int qg = 0; qg < 2; ++qg)
#pragma unroll
            for (int ks = 0; ks < 4; ++ks) t[qg][ks] = t[qg][ks] * QK_C;
        bf16x8 pf[2][2];
        sm_update(t, m, l, o, pf);
        pv_tile(Lb, pf, o, lane);
        __syncthreads();
    }
    o_store(Op, CROSS_W, 32 * wave, l, o, j, g);
}

}

enum Phase { PH_PRO = 0, PH_GU1, PH_DN1, PH_NORM2, PH_WIN, PH_KMEAN, PH_ATTN, PH_ONORM, PH_WOUT, PH_NORM3, PH_CQ, PH_CATTN, PH_CO, PH_NORM4, PH_GU2, PH_DN2, PH_FINAL, NPH };
enum In { I_X = 0, I_MEM, I_RELB, I_GFINAL, I_GFFN1, I_W1G, I_W1U, I_W1D, I_GMIX, I_WIN, I_BIN, I_SINKS, I_GOM, I_GOS, I_WOUT, I_GCROSS, I_GMEM, I_WCQ, I_WCK, I_WCV, I_WCO, I_GFFN2, I_W2G, I_W2U, I_W2D, N_IN };
struct Args { const float* in[N_IN]; float* out; unsigned char* ws; int ph_lo, ph_hi; };
static_assert(sizeof(Args) == N_IN * 8 + 8 + 8 + 8, "Args has no padding bytes");

constexpr float W2GU_SCALE = 64.f, W2D_SCALE = 128.f, H2_SCALE = 8.f, WOUT_SCALE = 64.f, WCQ_SCALE = 64.f, WIN8_SCALE = 64.f;
constexpr int IN_BF = 4096;
#define PG8_ALIGN true
#define PG8_SP2 true

__global__ void __launch_bounds__(NWAVES * 64, 2) hymba_fwd(Args args) {
    extern __shared__ __attribute__((aligned(16))) unsigned char lds[];
    LAS unsigned char* L = (LAS unsigned char*)lds;
    volatile LAS unsigned* MISC = (volatile LAS unsigned*)(L + MISC_OFF);
    const int tid = threadIdx.x, lane = tid & 63, wave = __builtin_amdgcn_readfirstlane(tid >> 6);
    const int G = gridDim.x, bid = blockIdx.x;
    unsigned char* ws = args.ws;
    gu32* ctl = (gu32*)(ws + WS_CTL);
    float* xs = args.out;
    float* kmean = (float*)(ws + WS_KMEAN);
    bf16* kvc = (bf16*)(ws + WS_KVC); bf16* memn = (bf16*)(ws + WS_MEMN); bf16* qc = (bf16*)(ws + WS_QC); bf16* oc = (bf16*)(ws + WS_OC);
    bf16* Wcq = (bf16*)(ws + WS_WCQ); bf16* Wckv = (bf16*)(ws + WS_WCKV); bf16* Wco = (bf16*)(ws + WS_WCO); bf16* Wout = (bf16*)(ws + WS_WOUT); bf16* Win = (bf16*)(ws + WS_WIN);
    bf16* Wgu1 = (bf16*)(ws + WS_WGU1); bf16* Wd1 = (bf16*)(ws + WS_WD1); bf16* Wgu2 = (bf16*)(ws + WS_WGU2); bf16* Wd2 = (bf16*)(ws + WS_WD2);
    bf16* NB_ = (bf16*)(ws + WS_N); bf16* HB = (bf16*)(ws + WS_H); bf16* PROJ = (bf16*)(ws + WS_H); unsigned char* n2f8 = ws + WS_N8;
    for (int u = tid; u < (LDS_BYTES - LDSCTL_OFF) / 4; u += NWAVES * 64) ((LAS unsigned*)(L + LDSCTL_OFF))[u] = 0u;
    __syncthreads();
    const int lo = args.ph_lo, hi = args.ph_hi;
    const bool use_bar = (hi - lo) > 1;
    XcdBarrier bar; bar.bar = (unsigned*)(ctl + CW_BAR); bar.x = 0; bar.st = nullptr;
    if (use_bar) bar = xcd_barrier_post((unsigned*)(ctl + CW_BAR), MISC + 8);
#ifndef PH_MASK
#define PH_MASK 0xFFFFFFFFu
#endif
#define IN(k) ((((PH_MASK) >> (k)) & 1u) && lo <= (k) && (k) < hi)
#ifndef DUP_MASK
#define DUP_MASK 0u
#endif
#define REPS(k) ((((DUP_MASK) >> (k)) & 1u) ? 2 : 1)
#define SEAM(k) do { if (IN(k) && IN((k) + 1)) xcd_barrier(bar); } while (0)
    const int gw = bid * NWAVES + wave, NGW = G * NWAVES;

    if (IN(PH_PRO)) _Pragma("unroll") for (int rep_ = 0; rep_ < REPS(PH_PRO); ++rep_) { if (rep_) xcd_barrier(bar);
        LAS float* scr = (LAS float*)(L + RING_OFF + wave * 16384);
        constexpr int I_FF = (DM / 64) * (FF / 32);
        constexpr int I_IN = (DM / 64) * (IN_W / 32), I_OUT = (DM / 64) * (DM / 32), I_C = (DM / 64) * (CROSS_W / 32), I_CO = (CROSS_W / 64) * (DM / 32);
        constexpr int NITEMS = 6 * I_FF + I_IN + I_OUT + 3 * I_C + I_CO;
        for (int it = gw; it < NITEMS; it += NGW) {
            int r = it;
            if (r < I_FF) { cvt_item(args.in[I_W1G], DM, FF, Wgu1, 128, 256, 0, scr, r, lane); continue; } r -= I_FF;
            if (r < I_FF) { cvt_item(args.in[I_W1U], DM, FF, Wgu1, 128, 256, 128, scr, r, lane); continue; } r -= I_FF;
            if (r < I_FF) { cvt_item(args.in[I_W1D], FF, DM, Wd1, DM, 0, 0, scr, r, lane); continue; } r -= I_FF;
            if (r < I_IN) { if (r % (IN_W / 32) < IN_BF / 32) cvt_item(args.in[I_WIN], DM, IN_W, Win, IN_W, 0, 0, scr, r, lane);
                             else cvt_item_f8(args.in[I_WIN], DM, IN_W, (unsigned char*)Win + (size_t)IN_BF * DM * 2, IN_W, 0, -IN_BF, WIN8_SCALE, scr, r, lane); continue; } r -= I_IN;
            if (r < I_OUT) { cvt_item_f8(args.in[I_WOUT], DM, DM, (unsigned char*)Wout, DM, 0, 0, WOUT_SCALE, scr, r, lane); continue; } r -= I_OUT;
            if (r < I_C) { cvt_item_f8(args.in[I_WCQ], DM, CROSS_W, (unsigned char*)Wcq, CROSS_W, 0, 0, WCQ_SCALE, scr, r, lane); continue; } r -= I_C;
            if (r < I_C) { cvt_item(args.in[I_WCK], DM, CROSS_W, Wckv, CROSS_W, 0, 0, scr, r, lane); continue; } r -= I_C;
            if (r < I_C) { cvt_item(args.in[I_WCV], DM, CROSS_W, Wckv, CROSS_W, 0, 512, scr, r, lane); continue; } r -= I_C;
            if (r < I_CO) { cvt_item(args.in[I_WCO], CROSS_W, DM, Wco, DM, 0, 0, scr, r, lane); continue; } r -= I_CO;
            if (r < I_FF) { cvt_item_f8(args.in[I_W2G], DM, FF, (unsigned char*)Wgu2, 128, 256, 0, W2GU_SCALE, scr, r, lane); continue; } r -= I_FF;
            if (r < I_FF) { cvt_item_f8(args.in[I_W2U], DM, FF, (unsigned char*)Wgu2, 128, 256, 128, W2GU_SCALE, scr, r, lane); continue; } r -= I_FF;
            cvt_item_f8(args.in[I_W2D], FF, DM, (unsigned char*)Wd2, DM, 0, 0, W2D_SCALE, scr, r, lane);
        }
        for (int m = gw; m < M; m += NGW) rms_row_bf16(args.in[I_X] + (size_t)m * DM, args.in[I_GFFN1], NB_ + (size_t)m * DM, lane);
        for (int m = gw; m < NB * NMEM; m += NGW) rms_row_bf16(args.in[I_MEM] + (size_t)m * DM, args.in[I_GMEM], memn + (size_t)m * DM, lane);
        __syncthreads();
    }
    SEAM(PH_PRO);

    if (IN(PH_GU1)) _Pragma("unroll") for (int rep_ = 0; rep_ < REPS(PH_GU1); ++rep_) { if (rep_) xcd_barrier(bar);
        { pg8::Gemm g{NB_, Wgu1, M, 2 * FF, DM}; pg8::StaticOrder S; S.init(M, 2 * FF, G, bid);
          pg8::EpiSwiGLU E{HB, FF};
          pg8::gemm_phase<pg8::EpiSwiGLU, pg8::StaticOrder, PG8_ALIGN, PG8_SP2>(L + RING_OFF, g, S, E); }
        { const int rem = ((M / 256) * (2 * FF / 256)) % G; const int c2 = (bid >= rem) ? bid - rem : bid + (G - rem);
          pg8::Gemm g{memn, Wckv, NB * NMEM, 1024, DM}; pg8::StaticOrder S; S.init(NB * NMEM, 1024, G, c2);
          pg8::EpiBf16B E{kvc, 1024, nullptr, 1.0f};
          pg8::gemm_phase<pg8::EpiBf16B, pg8::StaticOrder, PG8_ALIGN, PG8_SP2>(L + RING_OFF, g, S, E); }
    }
    SEAM(PH_GU1);

    if (IN(PH_DN1)) _Pragma("unroll") for (int rep_ = 0; rep_ < REPS(PH_DN1); ++rep_) { if (rep_) xcd_barrier(bar);
        pg8::Gemm g{HB, Wd1, M, DM, FF}; pg8::StaticOrder S; S.init(M, DM, G, bid);
        pg8::EpiResF32 E{args.in[I_X], xs, DM, 0.5f};
        pg8::gemm_phase<pg8::EpiResF32, pg8::StaticOrder, PG8_ALIGN, PG8_SP2>(L + RING_OFF, g, S, E);
    }
    SEAM(PH_DN1);

    if (IN(PH_NORM2)) _Pragma("unroll") for (int rep_ = 0; rep_ < REPS(PH_NORM2); ++rep_) { if (rep_) xcd_barrier(bar); for (int m = gw; m < M; m += NGW) rms_row_bf16_f8(xs + (size_t)m * DM, args.in[I_GMIX], NB_ + (size_t)m * DM, n2f8 + (size_t)m * DM, lane); }
    SEAM(PH_NORM2);

    if (IN(PH_WIN)) _Pragma("unroll") for (int rep_ = 0; rep_ < REPS(PH_WIN); ++rep_) { if (rep_) xcd_barrier(bar);
        { pg8::Gemm g{NB_, Win, M, IN_BF, DM}; pg8::StaticOrder S; S.init(M, IN_BF, G, bid);
          pg8::EpiProj E{PROJ, IN_W, args.in[I_BIN], kmean, COL_KM};
          pg8::gemm_phase<pg8::EpiProj, pg8::StaticOrder, PG8_ALIGN, PG8_SP2>(L + RING_OFF, g, S, E); }
        { pg8::Gemm g{(const bf16*)n2f8, (const bf16*)((unsigned char*)Win + (size_t)IN_BF * DM * 2), M, IN_W - IN_BF, DM}; pg8::StaticOrder S; S.init(M, IN_W - IN_BF, G, bid);
          pg8::EpiBf16B E{PROJ + IN_BF, IN_W, args.in[I_BIN] + IN_BF, 1.0f / WIN8_SCALE};
          pg8::gemm_phase<pg8::EpiBf16B, pg8::StaticOrder, PG8_ALIGN, PG8_SP2, true>(L + RING_OFF, g, S, E); }
    }
    SEAM(PH_WIN);


    if (IN(PH_ATTN)) _Pragma("unroll") for (int rep_ = 0; rep_ < REPS(PH_ATTN); ++rep_) { if (rep_) xcd_barrier(bar);
        for (int c = bid; c < 256; c += G) {
#ifndef NO_MOBA
            { const int b = c >> 6, h = (c >> 2) & 15, r = c & 3;
#pragma unroll 1
              for (int q = 0; q < 4; ++q) { const int qb = (q == 0) ? 15 - r : (q == 1) ? 11 - r : (q == 2) ? 4 + r : r;
                  att::moba_unit(L, PROJ, kmean, args.in[I_RELB], NB_, b, h, qb, tid); } }
#endif
#ifndef NO_SWA
            { const int b = c >> 6, kvh = (c >> 4) & 3, ib = c & 15;
#pragma unroll 1
              for (int q = 0; q < 4; ++q) att::swa_unit(L, PROJ, args.in[I_RELB], args.in[I_SINKS], NB_, b, kvh, 2 * ib + (q >> 1), q & 1, tid); }
#endif
        }
        __syncthreads();
    }
    SEAM(PH_ATTN);

    if (IN(PH_ONORM)) _Pragma("unroll") for (int rep_ = 0; rep_ < REPS(PH_ONORM); ++rep_) { if (rep_) xcd_barrier(bar); for (int m = gw; m < M; m += NGW) onorm_row_f8(NB_ + (size_t)m * DM, (unsigned char*)HB + (size_t)m * DM, args.in[I_GOM], args.in[I_GOS], lane); }
    SEAM(PH_ONORM);

    if (IN(PH_WOUT)) _Pragma("unroll") for (int rep_ = 0; rep_ < REPS(PH_WOUT); ++rep_) { if (rep_) xcd_barrier(bar);
        pg8::Gemm g{HB, Wout, M, DM, DM}; pg8::StaticOrder S; S.init(M, DM, G, bid);
        pg8::EpiResF32 E{xs, xs, DM, 1.0f / WOUT_SCALE};
        pg8::gemm_phase<pg8::EpiResF32, pg8::StaticOrder, PG8_ALIGN, PG8_SP2, true>(L + RING_OFF, g, S, E);
    }
    SEAM(PH_WOUT);

    if (IN(PH_NORM3)) _Pragma("unroll") for (int rep_ = 0; rep_ < REPS(PH_NORM3); ++rep_) { if (rep_) xcd_barrier(bar); for (int m = gw; m < M; m += NGW) rms_row_f8(xs + (size_t)m * DM, args.in[I_GCROSS], (unsigned char*)NB_ + (size_t)m * DM, lane); }
    SEAM(PH_NORM3);

    if (IN(PH_CQ)) _Pragma("unroll") for (int rep_ = 0; rep_ < REPS(PH_CQ); ++rep_) { if (rep_) xcd_barrier(bar);
        pg8::Gemm g{NB_, Wcq, M, CROSS_W, DM}; pg8::StaticOrder S; S.init(M, CROSS_W, G, bid);
        pg8::EpiBf16B E{qc, CROSS_W, nullptr, 1.0f / WCQ_SCALE};
        pg8::gemm_phase<pg8::EpiBf16B, pg8::StaticOrder, PG8_ALIGN, PG8_SP2, true>(L + RING_OFF, g, S, E);
    }
    SEAM(PH_CQ);

    if (IN(PH_CATTN)) _Pragma("unroll") for (int rep_ = 0; rep_ < REPS(PH_CATTN); ++rep_) { if (rep_) xcd_barrier(bar);
        for (int c = bid; c < 256; c += G) att::cross_unit(L, qc, kvc, oc, c >> 6, (c >> 4) & 3, c & 15, tid);
        __syncthreads();
    }
    SEAM(PH_CATTN);

    if (IN(PH_CO)) _Pragma("unroll") for (int rep_ = 0; rep_ < REPS(PH_CO); ++rep_) { if (rep_) xcd_barrier(bar);
        pg8::Gemm g{oc, Wco, M, DM, CROSS_W}; pg8::StaticOrder S; S.init(M, DM, G, bid);
        pg8::EpiResF32 E{xs, xs, DM, 1.0f};
        pg8::gemm_phase<pg8::EpiResF32, pg8::StaticOrder, PG8_ALIGN, PG8_SP2>(L + RING_OFF, g, S, E);
    }
    SEAM(PH_CO);

    if (IN(PH_NORM4)) _Pragma("unroll") for (int rep_ = 0; rep_ < REPS(PH_NORM4); ++rep_) { if (rep_) xcd_barrier(bar); for (int m = gw; m < M; m += NGW) rms_row_f8(xs + (size_t)m * DM, args.in[I_GFFN2], (unsigned char*)NB_ + (size_t)m * DM, lane); }
    SEAM(PH_NORM4);

    if (IN(PH_GU2)) _Pragma("unroll") for (int rep_ = 0; rep_ < REPS(PH_GU2); ++rep_) { if (rep_) xcd_barrier(bar);
        pg8::Gemm g{NB_, Wgu2, M, 2 * FF, DM}; pg8::StaticOrder S; S.init(M, 2 * FF, G, bid);
        pg8::EpiSwiGLUF8 E{(unsigned char*)HB, FF, 1.0f / W2GU_SCALE, H2_SCALE};
        pg8::gemm_phase<pg8::EpiSwiGLUF8, pg8::StaticOrder, PG8_ALIGN, PG8_SP2, true>(L + RING_OFF, g, S, E);
    }
    SEAM(PH_GU2);

    if (IN(PH_DN2)) _Pragma("unroll") for (int rep_ = 0; rep_ < REPS(PH_DN2); ++rep_) { if (rep_) xcd_barrier(bar);
        pg8::Gemm g{HB, Wd2, M, DM, FF}; pg8::StaticOrder S; S.init(M, DM, G, bid);
        pg8::EpiResF32 E{xs, xs, DM, 0.5f / (W2D_SCALE * H2_SCALE)};
        pg8::gemm_phase<pg8::EpiResF32, pg8::StaticOrder, PG8_ALIGN, PG8_SP2, true>(L + RING_OFF, g, S, E);
    }
    SEAM(PH_DN2);

    if (IN(PH_FINAL)) _Pragma("unroll") for (int rep_ = 0; rep_ < REPS(PH_FINAL); ++rep_) { if (rep_) xcd_barrier(bar); for (int m = gw; m < M; m += NGW) rms_row_f32(xs + (size_t)m * DM, args.in[I_GFINAL], lane); }
#undef IN
#undef SEAM
}

#ifndef MK_ONE_LAUNCH
#define MK_ONE_LAUNCH 1
#endif
extern "C" void kernel_launch(void* const* d_in, const int* in_sizes, int n_in, void* d_out, int out_size, void* d_ws, size_t ws_size, hipStream_t stream) {
    static int grid = 0;
    if (grid == 0) {
        if (n_in != N_IN || in_sizes[0] != M * DM || out_size != M * DM || ws_size < WS_END) { fprintf(stderr, "kernel_launch: unexpected shapes / workspace (n_in %d, in0 %d, out %d, ws %zu); nothing launched\n", n_in, n_in > 0 ? in_sizes[0] : -1, out_size, ws_size); grid = -1; return; }
        int dev = 0, cus = 0, per_cu = 0;
        if (hipGetDevice(&dev) != hipSuccess || hipDeviceGetAttribute(&cus, hipDeviceAttributeMultiprocessorCount, dev) != hipSuccess) { fprintf(stderr, "kernel_launch: hipGetDevice / hipDeviceGetAttribute failed\n"); grid = -1; return; }
        if (hipFuncSetAttribute((const void*)hymba_fwd, hipFuncAttributeMaxDynamicSharedMemorySize, LDS_BYTES) != hipSuccess) { fprintf(stderr, "kernel_launch: hipFuncSetAttribute failed\n"); grid = -1; return; }
        if (hipOccupancyMaxActiveBlocksPerMultiprocessor(&per_cu, (const void*)hymba_fwd, NWAVES * 64, LDS_BYTES) != hipSuccess || per_cu < 1) { fprintf(stderr, "kernel_launch: occupancy query reports %d workgroups per CU\n", per_cu); }
        (void)hipGetLastError();
        grid = cus;
    }
    if (grid < 0) return;
    (void)hipMemsetAsync((char*)d_ws + WS_CTL, 0, CTL_ZERO_BYTES, stream);
    Args a{};
    for (int i = 0; i < N_IN; ++i) a.in[i] = (const float*)d_in[i];
    a.out = (float*)d_out; a.ws = (unsigned char*)d_ws;
#if MK_ONE_LAUNCH
    a.ph_lo = 0; a.ph_hi = NPH;
    hipLaunchKernelGGL(hymba_fwd, dim3(grid), dim3(NWAVES * 64), LDS_BYTES, stream, a);
#else
    for (int ph = 0; ph < NPH; ++ph) { a.ph_lo = ph; a.ph_hi = ph + 1; hipLaunchKernelGGL(hymba_fwd, dim3(grid), dim3(NWAVES * 64), LDS_BYTES, stream, a); }
#endif
}
```
